# Optimizing an MI355X kernel written in HIP

```python
import math
import jax
import jax.numpy as jnp
from jax import lax
import numpy as np

D_MODEL = 1024
BATCH = 8
SEQ = 4096
DEPTH = 4

N_BRANCHES = 3
NORM_EPS = 1e-6
D_HYENA = 512
HYENA_EMB_DIM = 33
HYENA_FILTER_ORDER = 64
HYENA_FAST_DECAY_PCT = 0.3
HYENA_SLOW_DECAY_PCT = 1.5
HYENA_DECAY_TARGET = 1e-2
GLA_HEADS = 4
GLA_KEY_DIM = 512
GLA_VALUE_DIM = 512
GLA_HEAD_K = GLA_KEY_DIM // GLA_HEADS
GLA_HEAD_V = GLA_VALUE_DIM // GLA_HEADS
GLA_GATE_RANK = 16
GLA_GATE_NORMALIZER = 16.0
GLA_LOG_GATE_MIN = -1.0
GLA_CHUNK = 64
D_POOL = 512
POOL_WINDOWS = (2, 4, 8, 16)
POOL_GROUP = D_POOL // len(POOL_WINDOWS)
D_FF = 2816
IN_SPLITS = (3 * D_HYENA, GLA_KEY_DIM, GLA_KEY_DIM, GLA_VALUE_DIM, GLA_VALUE_DIM,
             2 * GLA_GATE_RANK, D_POOL, N_BRANCHES * D_MODEL)
D_IN = 3 * D_HYENA + 2 * GLA_KEY_DIM + 2 * GLA_VALUE_DIM + 2 * GLA_GATE_RANK + D_POOL + N_BRANCHES * D_MODEL

kernel_name = "hybrid_hyena_gla_pool_encoder"


def _split(t, sizes):
    out, off = [], 0
    for s in sizes:
        out.append(t[..., off:off + s])
        off += s
    return out


def _rms_norm(x, g):
    xf = x.astype(jnp.float32)
    y = xf * lax.rsqrt(jnp.mean(xf * xf, axis=-1, keepdims=True) + NORM_EPS)
    return (y * g.astype(jnp.float32)).astype(x.dtype)


def _dwconv3_centred(x, w, b):
    L = x.shape[1]
    xp = jnp.pad(x, ((0, 0), (1, 1), (0, 0)))
    return xp[:, :L] * w[0] + xp[:, 1:L + 1] * w[1] + xp[:, 2:] * w[2] + b


def _hyena_positional_features(L):
    t = jnp.linspace(0.0, 1.0, L, dtype=jnp.float32)[:, None]
    bands = (HYENA_EMB_DIM - 1) // 2
    w = 2.0 * math.pi * jnp.arange(L, dtype=jnp.float32)[:, None] / L
    f = jnp.linspace(1e-4, bands - 1, bands, dtype=jnp.float32)[None, :]
    ang = f * w
    z = jnp.concatenate([t, jnp.cos(ang), -jnp.sin(ang)], axis=-1)
    return t, z


def _hyena_filter(t, z, w1, b1, fr1, w2, b2, fr2, w3):
    L = t.shape[0]
    h = jnp.sin(fr1 * (z @ w1 + b1))
    h = jnp.sin(fr2 * (h @ w2 + b2))
    h = (h @ w3).astype(jnp.float32)
    max_decay = math.log(HYENA_DECAY_TARGET) / HYENA_FAST_DECAY_PCT
    min_decay = math.log(HYENA_DECAY_TARGET) / HYENA_SLOW_DECAY_PCT
    deltas = jnp.linspace(min_decay, max_decay, D_HYENA, dtype=jnp.float32)
    decay = jnp.exp(-t * jnp.abs(deltas))
    h_fwd = h[:, :D_HYENA] * decay
    h_bwd = h[:, D_HYENA:] * decay
    zero = jnp.zeros((1, D_HYENA), jnp.float32)
    return jnp.concatenate([h_fwd, zero, h_bwd[:0:-1]], axis=0)


def _hyena_mixer(u, conv_w, conv_b, t, z, w1, b1, fr1, w2, b2, fr2, w3, bias):
    B, L, _ = u.shape
    u = _dwconv3_centred(u, conv_w, conv_b)
    x0, x1, v = _split(u, (D_HYENA, D_HYENA, D_HYENA))
    zv = (x1 * v).astype(jnp.float32)
    k = _hyena_filter(t, z, w1, b1, fr1, w2, b2, fr2, w3)
    Zf = jnp.fft.rfft(zv, n=2 * L, axis=1)
    Kf = jnp.fft.rfft(k, n=2 * L, axis=0)
    y = jnp.fft.irfft(Zf * Kf[None], n=2 * L, axis=1)[:, :L]
    y = y + zv * bias.astype(jnp.float32)
    return (x0.astype(jnp.float32) * y).astype(u.dtype)


def _gla_direction(q, k, v, log_a, include_diag):
    B, L, H, DK = q.shape
    DV = v.shape[-1]
    C = GLA_CHUNK
    N = L // C
    q = q.reshape(B, N, C, H, DK)
    k = k.reshape(B, N, C, H, DK)
    v = v.reshape(B, N, C, H, DV)
    b = jnp.cumsum(log_a.reshape(B, N, C, H, DK), axis=2)
    b_last = b[:, :, -1]
    q_e = q * jnp.exp(b)
    k_e = k * jnp.exp(-b)
    scores = jnp.einsum('bnthd,bnshd->bnhts', q_e, k_e)
    mask = jnp.tril(jnp.ones((C, C), dtype=bool), k=0 if include_diag else -1)
    scores = jnp.where(mask, scores, 0.0)
    o_intra = jnp.einsum('bnhts,bnshe->bnthe', scores, v)
    k_dec = k * jnp.exp(b_last[:, :, None] - b)
    U = jnp.einsum('bnshd,bnshe->bnhde', k_dec, v)
    decay = jnp.exp(b_last)

    def step(S, inp):
        dec, inc = inp
        return dec[..., None] * S + inc, S

    S0 = jnp.zeros((B, H, DK, DV), U.dtype)
    _, S_prev = lax.scan(step, S0, (jnp.moveaxis(decay, 1, 0), jnp.moveaxis(U, 1, 0)))
    S_prev = jnp.moveaxis(S_prev, 0, 1)
    o_inter = jnp.einsum('bnthd,bnhde->bnthe', q_e, S_prev)
    return (o_intra + o_inter).reshape(B, L, H, DV)


def _gla_mixer(q, k, v, g, gate_lr, gate_w2, gate_b, norm_g):
    B, L, _ = q.shape
    q = q.reshape(B, L, GLA_HEADS, GLA_HEAD_K) * (GLA_HEAD_K ** -0.5)
    k = k.reshape(B, L, GLA_HEADS, GLA_HEAD_K)
    v = v.reshape(B, L, GLA_HEADS, GLA_HEAD_V)
    lr = gate_lr.reshape(B, L, 2, GLA_GATE_RANK)
    gk = jnp.einsum('blzr,zrd->blzd', lr, gate_w2) + gate_b
    log_a = jnp.maximum(jax.nn.log_sigmoid(gk.astype(jnp.float32)) / GLA_GATE_NORMALIZER,
                        GLA_LOG_GATE_MIN).reshape(B, L, 2, GLA_HEADS, GLA_HEAD_K)
    o_fwd = _gla_direction(q, k, v, log_a[:, :, 0], True)
    fl = lambda a: jnp.flip(a, axis=1)
    o_bwd = fl(_gla_direction(fl(q), fl(k), fl(v), fl(log_a[:, :, 1]), False))
    o = _rms_norm(o_fwd + o_bwd, norm_g)
    return o.reshape(B, L, GLA_VALUE_DIM).astype(g.dtype) * jax.nn.silu(g)


def _pool_mixer(u, pool_w, pool_scale):
    B, L, _ = u.shape
    pos = jnp.arange(L)
    groups = []
    for gi, w in enumerate(POOL_WINDOWS):
        xg = u[..., gi * POOL_GROUP:(gi + 1) * POOL_GROUP].astype(jnp.float32)
        half = w // 2
        xp = jnp.pad(xg, ((0, 0), (half, half), (0, 0)))
        cs = jnp.pad(jnp.cumsum(xp, axis=1), ((0, 0), (1, 0), (0, 0)))
        wsum = cs[:, w:w + L] - cs[:, :L]
        count = (jnp.minimum(pos + half, L) - jnp.maximum(pos - half, 0)).astype(jnp.float32)
        groups.append(wsum / count[None, :, None] - xg)
    d = jnp.stack(groups, axis=2)
    y = jnp.einsum('blgc,gcd->blgd', d, pool_w.astype(jnp.float32)).reshape(B, L, D_POOL)
    return (y * pool_scale.astype(jnp.float32)).astype(u.dtype)


def setup_inputs(seed: int = 0) -> dict:
    key = jax.random.key(seed)
    ks = iter(jax.random.split(key, 40))
    f32 = jnp.float32
    n = DEPTH
    FO = HYENA_FILTER_ORDER

    def nrm(shape, scale):
        return jax.random.normal(next(ks), shape, f32) * scale

    def gain(shape, noise=0.05):
        return 1.0 + nrm(shape, noise)

    return {
        "x": nrm((BATCH, SEQ, D_MODEL), 1.0),
        "norm_mix_pre": gain((n, D_MODEL)),
        "norm_mix_post": gain((n, D_MODEL)),
        "norm_ffn_pre": gain((n, D_MODEL)),
        "norm_ffn_post": gain((n, D_MODEL)),
        "w_in": nrm((n, D_MODEL, D_IN), D_MODEL ** -0.5),
        "hy_conv_w": nrm((n, 3, 3 * D_HYENA), 3 ** -0.5),
        "hy_conv_b": nrm((n, 3 * D_HYENA), 0.02),
        "hy_filt_w1": nrm((n, HYENA_EMB_DIM, FO), HYENA_EMB_DIM ** -0.5),
        "hy_filt_b1": nrm((n, FO), 0.1),
        "hy_filt_freq1": gain((n, FO), 0.01),
        "hy_filt_w2": nrm((n, FO, FO), FO ** -0.5),
        "hy_filt_b2": nrm((n, FO), 0.1),
        "hy_filt_freq2": gain((n, FO), 0.01),
        "hy_filt_w3": nrm((n, FO, 2 * D_HYENA), 0.005),
        "hy_bias": nrm((n, D_HYENA), 1.0),
        "gla_gate_w2": nrm((n, 2, GLA_GATE_RANK, GLA_KEY_DIM), GLA_GATE_RANK ** -0.5),
        "gla_gate_b": nrm((n, 2, GLA_KEY_DIM), 0.1),
        "gla_norm": gain((n, GLA_HEAD_V), 0.01),
        "pool_w": nrm((n, len(POOL_WINDOWS), POOL_GROUP, POOL_GROUP), POOL_GROUP ** -0.5),
        "pool_scale": gain((n, D_POOL), 0.1),
        "w_br_hyena": nrm((n, D_HYENA, D_MODEL), D_HYENA ** -0.5),
        "w_br_gla": nrm((n, GLA_VALUE_DIM, D_MODEL), GLA_VALUE_DIM ** -0.5),
        "w_br_pool": nrm((n, D_POOL, D_MODEL), D_POOL ** -0.5),
        "w_out": nrm((n, D_MODEL, D_MODEL), D_MODEL ** -0.5),
        "ffn_w_up": nrm((n, D_MODEL, 2 * D_FF), D_MODEL ** -0.5),
        "ffn_conv_w": nrm((n, 3, D_FF), 3 ** -0.5),
        "ffn_conv_b": nrm((n, D_FF), 0.02),
        "ffn_w_down": nrm((n, D_FF, D_MODEL), D_FF ** -0.5),
    }


def reference(x, norm_mix_pre, norm_mix_post, norm_ffn_pre, norm_ffn_post, w_in,
              hy_conv_w, hy_conv_b, hy_filt_w1, hy_filt_b1, hy_filt_freq1, hy_filt_w2,
              hy_filt_b2, hy_filt_freq2, hy_filt_w3, hy_bias, gla_gate_w2, gla_gate_b,
              gla_norm, pool_w, pool_scale, w_br_hyena, w_br_gla, w_br_pool, w_out,
              ffn_w_up, ffn_conv_w, ffn_conv_b, ffn_w_down):
    B, L, _ = x.shape
    t_pos, z_pos = _hyena_positional_features(L)
    for i in range(DEPTH):
        h = _rms_norm(x, norm_mix_pre[i])
        proj = h @ w_in[i]
        u_hy, q, k, v, g_out, gate_lr, u_pool, gate_logits = _split(proj, IN_SPLITS)
        y_hy = _hyena_mixer(u_hy, hy_conv_w[i], hy_conv_b[i], t_pos, z_pos,
                            hy_filt_w1[i], hy_filt_b1[i], hy_filt_freq1[i], hy_filt_w2[i],
                            hy_filt_b2[i], hy_filt_freq2[i], hy_filt_w3[i], hy_bias[i])
        y_gla = _gla_mixer(q, k, v, g_out, gate_lr, gla_gate_w2[i], gla_gate_b[i], gla_norm[i])
        y_pool = _pool_mixer(u_pool, pool_w[i], pool_scale[i])
        gates = jax.nn.sigmoid(gate_logits).reshape(B, L, N_BRANCHES, D_MODEL)
        merged = (gates[:, :, 0] * (y_hy @ w_br_hyena[i])
                  + gates[:, :, 1] * (y_gla @ w_br_gla[i])
                  + gates[:, :, 2] * (y_pool @ w_br_pool[i]))
        x = x + _rms_norm(merged @ w_out[i], norm_mix_post[i])
        h = _rms_norm(x, norm_ffn_pre[i])
        a, b = _split(h @ ffn_w_up[i], (D_FF, D_FF))
        a = _dwconv3_centred(a, ffn_conv_w[i], ffn_conv_b[i])
        y = (jax.nn.gelu(a, approximate=False) * b) @ ffn_w_down[i]
        x = x + _rms_norm(y, norm_ffn_post[i])
    return x
```

```cpp
#include <hip/hip_runtime.h>
#include <hip/hip_cooperative_groups.h>
#include <cstdio>
#include <cstdint>
namespace cg = cooperative_groups;
#ifndef MK_PER_PHASE_LAUNCH
#define MK_PER_PHASE_LAUNCH 0
#endif
#include <hip/hip_runtime.h>
#include <cstdio>
#include <cstdint>
namespace pg8 {
#define PG8_LAS __attribute__((address_space(3)))
typedef unsigned short bf16_t;
typedef short bf16x8 __attribute__((ext_vector_type(8)));
typedef float f32x4 __attribute__((ext_vector_type(4)));
typedef unsigned u32x4 __attribute__((ext_vector_type(4)));
constexpr int BM = 256, BK = 64, HALF = 128, HTB = HALF * BK * 2  , STAGE_BYTES = 8 * HTB, NXCD = 8, WGM = 8;

__host__ __device__ __forceinline__ int lds_byte(int r, int c) { const int st = (r >> 4) * 2 + (c >> 5), rr = r & 15, cc = c & 31, ob = rr * 64 + cc * 2; return st * 1024 + (ob ^ (((ob >> 9) & 1) << 5)); }
__host__ __device__ __forceinline__ void stage_rc(int b, int& R, int& C) { const int st = b / 1024, sb = b % 1024, swz = sb ^ (((sb >> 9) & 1) << 5); R = (st >> 1) * 16 + swz / 64; C = (st & 1) * 32 + (swz % 64) / 2; }
__host__ __device__ __forceinline__ int perm32(int rho) { const int n = rho >> 4, i = rho & 15; return 8 * (i >> 2) + 4 * n + (i & 3); }

struct Unit { int pm, pn; };
struct Gemm { const bf16_t* A; const bf16_t* Bt; int M, N, K, lda, ldb; };

struct StaticOrder {
    int nM, nN, nwg, G, c;
    __host__ __device__ void init(int M, int N, int G_, int c_) { nM = M / BM; nN = N / BM; nwg = nM * nN; G = G_; c = c_; }
    __host__ __device__ bool next(int i, Unit& u) const {
        const long L = (long)i * G + c; if (L >= nwg) return false;
        int wgid = (int)L; { const int q = nwg / NXCD, r = nwg % NXCD, xcd = wgid % NXCD, off = wgid / NXCD; wgid = (xcd < r ? xcd * (q + 1) : r * (q + 1) + (xcd - r) * q) + off; }
        const int nig = WGM * nN, gid = wgid / nig, fm = gid * WGM, gsz = (nM - fm) < WGM ? (nM - fm) : WGM;
        u.pm = fm + ((wgid % nig) % gsz); u.pn = (wgid % nig) / gsz; return true;
    }
    __device__ __forceinline__ void a_ready(const Unit&) const {}
    __device__ __forceinline__ void done(const Unit&) const {}
};
typedef float f32x2 __attribute__((ext_vector_type(2)));
typedef __bf16 bf16x2_t __attribute__((ext_vector_type(2)));
__device__ __forceinline__ unsigned cvt_pk_bf16(float lo, float hi) { const f32x2 v = {lo, hi}; const bf16x2_t h = __builtin_convertvector(v, bf16x2_t); return __builtin_bit_cast(unsigned, h); }
__device__ __forceinline__ f32x2 gelu_pk(f32x2 v) {
    const f32x2 av = __builtin_elementwise_abs(v), d = av * 0.2316418882f + 1.0f;
    f32x2 t; t.x = __builtin_amdgcn_rcpf(d.x); t.y = __builtin_amdgcn_rcpf(d.y);
    f32x2 q = t * 0.5307027145f + (-0.7265760135f); q = q * t + 0.7107068705f; q = q * t + (-0.142248368f); q = q * t + 0.127414796f; q = q * t;
    const f32x2 s = (v * v) * (-0.72134752044f);
    f32x2 e; e.x = __builtin_amdgcn_exp2f(s.x); e.y = __builtin_amdgcn_exp2f(s.y);
    const f32x2 m = v * (q * e), r = v - m;
    f32x2 o; o.x = v.x < 0.f ? m.x : r.x; o.y = v.y < 0.f ? m.y : r.y; return o;
}
template <class Epi, class Sched, bool ALIGN_EPI = false, bool SP2 = false>
__device__ __forceinline__ void gemm_phase(PG8_LAS unsigned char* lds, const Gemm g, const Sched& S, const Epi& E) {
    int tid_ = threadIdx.x; asm volatile("" : "+v"(tid_)); const int tid = tid_, wid = __builtin_amdgcn_readfirstlane(tid >> 6), lane = tid & 63, wr = wid >> 2, wc = wid & 3, fr = lane & 15, fq = lane >> 4;
    const int K = g.K, nt = K / BK;
    unsigned voffA[2], voffB[2];
#pragma unroll
    for (int i = 0; i < 2; ++i) { int R, C; stage_rc(tid * 16 + i * 8192, R, C); const int Rb = Epi::PERM ? ((R & ~31) + perm32(R & 31)) : R;
        voffA[i] = (unsigned)(R * g.lda + C) * 2u; voffB[i] = (unsigned)(Rb * g.ldb + C) * 2u; }
    const size_t kstep = (size_t)(BK * 2);
    const size_t hstepA = (size_t)HALF * g.lda * 2, hstepB = (size_t)HALF * g.ldb * 2;
    const size_t tstepA = 2 * hstepA, tstepB = 2 * hstepB;
    const unsigned ldsw = (unsigned)wid * 1024u;
    const int aoff = lds_byte(wr * 64 + fr, fq * 8), boff = lds_byte(wc * 32 + fr, fq * 8);
#define PG8_SA(b, h) (((b) * 2 + (h)) * HTB)
#define PG8_SB(b, h) ((4 + (b) * 2 + (h)) * HTB)
#define PG8_STAGE(bufoff, gbase, voff) do { _Pragma("unroll") for (int _i = 0; _i < 2; ++_i) \
        __builtin_amdgcn_global_load_lds((const unsigned*)((const char*)(gbase) + (voff)[_i]), (PG8_LAS unsigned*)(lds + (bufoff) + ldsw + _i * 8192), 16, 0, 0); } while (0)
#define PG8_LDA(dst, b, h) do { _Pragma("unroll") for (int m = 0; m < 4; ++m) _Pragma("unroll") for (int k = 0; k < 2; ++k) dst[m][k] = *(const PG8_LAS bf16x8*)(lds + PG8_SA(b, h) + aoff + m * 2048 + k * 1024); } while (0)
#define PG8_LDB(dst, b, h) do { _Pragma("unroll") for (int n = 0; n < 2; ++n) _Pragma("unroll") for (int k = 0; k < 2; ++k) dst[n][k] = *(const PG8_LAS bf16x8*)(lds + PG8_SB(b, h) + boff + n * 2048 + k * 1024); } while (0)
#define PG8_MMA(ai, bj, At, Bt) do { __builtin_amdgcn_s_setprio(1); _Pragma("unroll") for (int m = 0; m < 4; ++m) _Pragma("unroll") for (int n = 0; n < 2; ++n) _Pragma("unroll") for (int k = 0; k < 2; ++k) \
        acc[ai][bj][m][n] = __builtin_amdgcn_mfma_f32_16x16x32_bf16(Bt[n][k], At[m][k], acc[ai][bj][m][n], 0, 0, 0); __builtin_amdgcn_s_setprio(0); } while (0)
#define PG8_WAIT_V(n) asm volatile("s_waitcnt vmcnt(" #n ")" ::: "memory")
#define PG8_WAIT_L(n) asm volatile("s_waitcnt lgkmcnt(" #n ")" ::: "memory")
#define PG8_BAR __builtin_amdgcn_s_barrier()
#define PG8_SCHED __builtin_amdgcn_sched_barrier(0)
    Unit cur, nxt; int ui = 0;
    if (!S.next(0, cur)) return;
    f32x4 acc[2][2][4][2];
#pragma unroll
    for (int a = 0; a < 2; ++a)
#pragma unroll
        for (int b = 0; b < 2; ++b)
#pragma unroll
            for (int m = 0; m < 4; ++m)
#pragma unroll
                for (int n = 0; n < 2; ++n) acc[a][b][m][n] = (f32x4){0.f, 0.f, 0.f, 0.f};
    bf16x8 At[4][2], B0[2][2], B1[2][2];
    const char* cA = (const char*)g.A + (size_t)cur.pm * tstepA; const char* cB = (const char*)g.Bt + (size_t)cur.pn * tstepB;
    S.a_ready(cur);
    if constexpr (SP2) {
        PG8_STAGE(PG8_SB(0, 0), cB, voffB); PG8_STAGE(PG8_SB(0, 1), cB + hstepB, voffB); PG8_STAGE(PG8_SA(0, 0), cA, voffA); PG8_STAGE(PG8_SA(0, 1), cA + hstepA, voffA);
        if (wr == 1) PG8_BAR;
        PG8_WAIT_V(2); PG8_BAR;
        PG8_STAGE(PG8_SB(1, 0), cB + kstep, voffB); PG8_STAGE(PG8_SA(1, 0), cA + kstep, voffA); PG8_STAGE(PG8_SB(1, 1), cB + hstepB + kstep, voffB);
        PG8_WAIT_V(6); PG8_BAR;
    } else {
        PG8_STAGE(PG8_SB(0, 0), cB, voffB); PG8_STAGE(PG8_SA(0, 0), cA, voffA); PG8_STAGE(PG8_SB(0, 1), cB + hstepB, voffB); PG8_STAGE(PG8_SA(0, 1), cA + hstepA, voffA);
        if (wr == 1) PG8_BAR;
        PG8_WAIT_V(4); PG8_BAR;
        PG8_STAGE(PG8_SB(1, 0), cB + kstep, voffB); PG8_STAGE(PG8_SA(1, 0), cA + kstep, voffA); PG8_STAGE(PG8_SB(1, 1), cB + hstepB + kstep, voffB);
        PG8_WAIT_V(6); PG8_BAR;
    }
    for (;;) {
        const bool has_next = S.next(ui + 1, nxt);
        const char* nA = has_next ? (const char*)g.A + (size_t)nxt.pm * tstepA : cA; const char* nB = has_next ? (const char*)g.Bt + (size_t)nxt.pn * tstepB : cB;
        for (int t = 0; t < nt; t += 2) {
            const bool last = (t == nt - 2);
            const char* a1 = cA + (size_t)(t + 1) * kstep;
            const char* a2 = last ? nA : cA + (size_t)(t + 2) * kstep; const char* b2 = last ? nB : cB + (size_t)(t + 2) * kstep;
            const char* a3 = a2 + kstep; const char* b3 = b2 + kstep;
            if (last && has_next) S.a_ready(nxt);
            if constexpr (SP2) {
            PG8_LDB(B0, 0, 0); PG8_LDB(B1, 0, 1); PG8_SCHED; PG8_LDA(At, 0, 0); PG8_STAGE(PG8_SA(1, 1), a1 + hstepA, voffA);
            PG8_WAIT_V(8); PG8_WAIT_L(0); PG8_BAR; PG8_MMA(0, 0, At, B0); PG8_MMA(0, 1, At, B1); PG8_BAR; PG8_SCHED;
            PG8_LDA(At, 0, 1); PG8_STAGE(PG8_SB(0, 0), b2, voffB); PG8_STAGE(PG8_SB(0, 1), b2 + hstepB, voffB); PG8_STAGE(PG8_SA(0, 0), a2, voffA);
            PG8_WAIT_V(8); PG8_WAIT_L(0); PG8_BAR; PG8_MMA(1, 0, At, B0); PG8_MMA(1, 1, At, B1); PG8_BAR; PG8_SCHED;
            PG8_LDB(B0, 1, 0); PG8_LDB(B1, 1, 1); PG8_SCHED; PG8_LDA(At, 1, 0); PG8_STAGE(PG8_SA(0, 1), a2 + hstepA, voffA);
            PG8_WAIT_V(8); PG8_WAIT_L(0); PG8_BAR; PG8_MMA(0, 0, At, B0); PG8_MMA(0, 1, At, B1); PG8_BAR; PG8_SCHED;
            PG8_LDA(At, 1, 1); PG8_STAGE(PG8_SB(1, 0), b3, voffB); PG8_STAGE(PG8_SB(1, 1), b3 + hstepB, voffB); PG8_STAGE(PG8_SA(1, 0), a3, voffA);
            PG8_WAIT_V(8); PG8_WAIT_L(0); PG8_BAR; PG8_MMA(1, 0, At, B0); PG8_MMA(1, 1, At, B1); PG8_BAR; PG8_SCHED;
            } else {
            PG8_LDB(B0, 0, 0); PG8_SCHED; PG8_LDA(At, 0, 0); PG8_STAGE(PG8_SA(1, 1), a1 + hstepA, voffA);
            PG8_WAIT_L(8); PG8_BAR; PG8_WAIT_L(0); PG8_MMA(0, 0, At, B0); PG8_BAR; PG8_SCHED;
            PG8_LDB(B1, 0, 1); PG8_STAGE(PG8_SB(0, 0), b2, voffB);
            PG8_BAR; PG8_WAIT_L(0); PG8_MMA(0, 1, At, B1); PG8_BAR;
            PG8_LDA(At, 0, 1); PG8_STAGE(PG8_SA(0, 0), a2, voffA);
            PG8_BAR; PG8_WAIT_L(0); PG8_MMA(1, 0, At, B0); PG8_BAR; PG8_SCHED;
            PG8_STAGE(PG8_SB(0, 1), b2 + hstepB, voffB);
            PG8_WAIT_V(6); PG8_BAR; PG8_MMA(1, 1, At, B1); PG8_BAR;
            PG8_LDB(B0, 1, 0); PG8_SCHED; PG8_LDA(At, 1, 0); PG8_STAGE(PG8_SA(0, 1), a2 + hstepA, voffA);
            PG8_WAIT_L(8); PG8_BAR; PG8_WAIT_L(0); PG8_MMA(0, 0, At, B0); PG8_BAR; PG8_SCHED;
            PG8_LDB(B1, 1, 1); PG8_STAGE(PG8_SB(1, 0), b3, voffB);
            PG8_BAR; PG8_WAIT_L(0); PG8_MMA(0, 1, At, B1); PG8_BAR;
            PG8_LDA(At, 1, 1); PG8_STAGE(PG8_SA(1, 0), a3, voffA);
            PG8_BAR; PG8_WAIT_L(0); PG8_MMA(1, 0, At, B0); PG8_BAR; PG8_SCHED;
            PG8_STAGE(PG8_SB(1, 1), b3 + hstepB, voffB);
            PG8_WAIT_V(6); PG8_BAR; PG8_MMA(1, 1, At, B1); PG8_BAR;
            }
        }
        if constexpr (ALIGN_EPI) { if (wr == 0) PG8_BAR; }
        if constexpr (!Epi::AFTER_DRAIN) { E(acc, cur, wr, wc, fr, fq); S.done(cur); }
        if (!has_next) break;
#pragma unroll
        for (int a = 0; a < 2; ++a)
#pragma unroll
            for (int b = 0; b < 2; ++b)
#pragma unroll
                for (int m = 0; m < 4; ++m)
#pragma unroll
                    for (int n = 0; n < 2; ++n) acc[a][b][m][n] = (f32x4){0.f, 0.f, 0.f, 0.f};
        cur = nxt; cA = nA; cB = nB; ++ui;
        if constexpr (ALIGN_EPI) { if (wr == 1) PG8_BAR; }
    }
    PG8_WAIT_V(0);
    if constexpr (!ALIGN_EPI) { if (wr == 0) PG8_BAR; }
    PG8_BAR;
    if constexpr (Epi::AFTER_DRAIN) { E.fused(acc, cur, wr, wc, fr, fq, lds, wid, lane); S.done(cur); }
#undef PG8_SA
#undef PG8_SB
#undef PG8_STAGE
#undef PG8_LDA
#undef PG8_LDB
#undef PG8_MMA
#undef PG8_WAIT_V
#undef PG8_WAIT_L
#undef PG8_BAR
#undef PG8_SCHED
}
}


using pg8::bf16_t; using pg8::bf16x8; using pg8::f32x4; using pg8::u32x4; using pg8::Unit; using pg8::cvt_pk_bf16; using pg8::f32x2;
typedef unsigned u32x2 __attribute__((ext_vector_type(2)));

constexpr int D = 1024, NB = 8, L = 4096, M = NB * L, DEPTH = 4, DIN = 7200, DFF = 2816;
constexpr int C_LR = 3584, C_POOL = 3616, C_GATE = 4128;
constexpr int NWIN = 4352;
constexpr float EPS = 1e-6f;
constexpr size_t SZ512 = (size_t)M * 512 * 2;
constexpr size_t WS_WIN = 0;
constexpr size_t WS_WG = WS_WIN + (size_t)NWIN * 1024 * 2;
constexpr size_t WS_WBR = WS_WG + (size_t)3072 * 1024 * 2;
constexpr size_t WS_WOUT = WS_WBR + (size_t)3 * 1024 * 512 * 2;
constexpr size_t WS_H = WS_WOUT + (size_t)1024 * 1024 * 2;
constexpr size_t WS_HID = WS_H + (size_t)M * 1024 * 2;
constexpr size_t WS_TW8 = WS_HID + (size_t)4 * 4096 * 64 * 4;
constexpr size_t WS_BAR = WS_TW8 + 4096 * 8;
constexpr size_t WS_AR = WS_BAR + 16384;
constexpr size_t WS_UT = WS_AR;
constexpr size_t WS_QKVG = WS_UT + 3 * SZ512;
constexpr size_t WS_POOL = WS_QKVG + 4 * SZ512;
constexpr size_t WS_LR = WS_POOL + SZ512;
constexpr size_t WS_YHY = WS_LR + (size_t)M * 32 * 2;
constexpr size_t WS_YGLA = WS_YHY + SZ512;
constexpr size_t WS_YPOOL = WS_YGLA + SZ512;
constexpr size_t WS_OB = WS_YPOOL + SZ512;
constexpr size_t WS_END_MIX = WS_OB + SZ512;
constexpr size_t WS_TMP = WS_UT;
constexpr size_t WS_MERGED = WS_TMP + (size_t)M * 3072 * 2;
static_assert(WS_MERGED + (size_t)M * 1024 * 2 <= WS_YHY, "merge scratch must end before the live branch outputs");
constexpr size_t WS_AB = WS_AR;
constexpr size_t WS_ACT = WS_AR;
constexpr size_t WS_SIDE = WS_ACT + (size_t)M * 2816 * 2;
constexpr size_t WS_END_FFN = WS_AB + (size_t)M * 5632 * 2;
constexpr size_t WS_XBW = WS_AR + ((size_t)256 << 20);
static_assert(WS_XBW >= WS_SIDE + (size_t)(M / 64) * 6 * 2816 * 2 && WS_XBW + (size_t)M * 1024 * 2 <= WS_END_MIX, "residual copy must sit behind the FFN activations, inside the arena");
constexpr size_t WS_TAPS = WS_END_MIX;
constexpr size_t WS_WUP = WS_TAPS + (size_t)1024 * 4096 * 4;
constexpr size_t WS_WDN = WS_WUP + (size_t)5632 * 1024 * 2;
constexpr size_t WS_END = WS_WDN + (size_t)1024 * 2816 * 2;
static_assert(WS_END_FFN <= WS_TAPS, "FFN-stage buffers must end before the taps");
constexpr int LDS_BYTES = 132 * 1024;
constexpr int N_PHASES = 1 + DEPTH * 10;
#ifndef PHMASK
#define PHMASK 0x7FF
#endif

__device__ __forceinline__ float bf2f(unsigned u16) { return __uint_as_float(u16 << 16); }
__device__ __forceinline__ float bflo(unsigned w) { return __uint_as_float(w << 16); }
__device__ __forceinline__ float bfhi(unsigned w) { return __uint_as_float(w & 0xffff0000u); }
__device__ __forceinline__ bf16_t f2bf(float f) { const __bf16 h = (__bf16)f; return __builtin_bit_cast(bf16_t, h); }
__device__ __forceinline__ void unpack8(const u32x4 w, float* v) {
    v[0] = bflo(w.x); v[1] = bfhi(w.x); v[2] = bflo(w.y); v[3] = bfhi(w.y); v[4] = bflo(w.z); v[5] = bfhi(w.z); v[6] = bflo(w.w); v[7] = bfhi(w.w); }
__device__ __forceinline__ u32x4 pack8(const float* v) { u32x4 w; w.x = cvt_pk_bf16(v[0], v[1]); w.y = cvt_pk_bf16(v[2], v[3]); w.z = cvt_pk_bf16(v[4], v[5]); w.w = cvt_pk_bf16(v[6], v[7]); return w; }
__device__ __forceinline__ float wave_sum(float v) {
#pragma unroll
    for (int o = 32; o; o >>= 1) v += __shfl_xor(v, o);
    return v; }

struct EpiPlain {
    static constexpr bool PERM = true, AFTER_DRAIN = false;
    bf16_t* O; int ldc;
    __device__ __forceinline__ void operator()(const f32x4 (&acc)[2][2][4][2], const Unit& u, int wr, int wc, int fr, int fq) const {
        const int row0 = u.pm * 256 + wr * 64 + fr, col0 = u.pn * 256 + wc * 32 + 8 * fq;
#pragma unroll
        for (int ai = 0; ai < 2; ++ai)
#pragma unroll
            for (int m = 0; m < 4; ++m) { bf16_t* rowp = O + (size_t)(row0 + ai * 128 + m * 16) * ldc + col0;
#pragma unroll
                for (int bj = 0; bj < 2; ++bj) { const f32x4 v0 = acc[ai][bj][m][0], v1 = acc[ai][bj][m][1];
                    u32x4 w; w.x = cvt_pk_bf16(v0[0], v0[1]); w.y = cvt_pk_bf16(v0[2], v0[3]); w.z = cvt_pk_bf16(v1[0], v1[1]); w.w = cvt_pk_bf16(v1[2], v1[3]);
                    *(u32x4*)(rowp + bj * 128) = w; } }
    }
};
struct EpiUT {
    static constexpr bool PERM = true, AFTER_DRAIN = false;
    bf16_t* UT;
    __device__ __forceinline__ void operator()(const f32x4 (&acc)[2][2][4][2], const Unit& u, int wr, int wc, int fr, int fq) const {
        const int ch0 = u.pm * 256 + wr * 64 + fr, tok0 = u.pn * 256 + wc * 32 + 8 * fq;
#pragma unroll
        for (int ai = 0; ai < 2; ++ai)
#pragma unroll
            for (int m = 0; m < 4; ++m) { const int ch = ch0 + ai * 128 + m * 16;
#pragma unroll
                for (int bj = 0; bj < 2; ++bj) { const int tok = tok0 + bj * 128, b = tok >> 12, t = tok & 4095;
                    const f32x4 v0 = acc[ai][bj][m][0], v1 = acc[ai][bj][m][1];
                    u32x4 w; w.x = cvt_pk_bf16(v0[0], v0[1]); w.y = cvt_pk_bf16(v0[2], v0[3]); w.z = cvt_pk_bf16(v1[0], v1[1]); w.w = cvt_pk_bf16(v1[2], v1[3]);
                    *(u32x4*)(UT + ((size_t)b * 1536 + ch) * 4096 + t) = w; } }
    }
};
struct EpiProj {
    static constexpr bool PERM = true, AFTER_DRAIN = false;
    bf16_t* QKVG; bf16_t* POOL; bf16_t* LRB;
    __device__ __forceinline__ void operator()(const f32x4 (&acc)[2][2][4][2], const Unit& u, int wr, int wc, int fr, int fq) const {
        const int row0 = u.pm * 256 + wr * 64 + fr; const int cl = wc * 32 + 8 * fq;
        bf16_t* base; int ldc; bool lr = false;
        if (u.pn < 8) { base = QKVG + u.pn * 256 + cl; ldc = 2048; }
        else if (u.pn < 10) { base = POOL + (u.pn - 8) * 256 + cl; ldc = 512; }
        else { base = LRB + cl; ldc = 32; lr = true; }
#pragma unroll
        for (int ai = 0; ai < 2; ++ai)
#pragma unroll
            for (int m = 0; m < 4; ++m) { bf16_t* rowp = base + (size_t)(row0 + ai * 128 + m * 16) * ldc;
#pragma unroll
                for (int bj = 0; bj < 2; ++bj) { const f32x4 v0 = acc[ai][bj][m][0], v1 = acc[ai][bj][m][1];
                    u32x4 w; w.x = cvt_pk_bf16(v0[0], v0[1]); w.y = cvt_pk_bf16(v0[2], v0[3]); w.z = cvt_pk_bf16(v1[0], v1[1]); w.w = cvt_pk_bf16(v1[2], v1[3]);
                    if (!lr) *(u32x4*)(rowp + bj * 128) = w;
                    else if (bj == 0 && wc == 0) *(u32x4*)(rowp) = w; } }
    }
};
struct EpiGate {
    static constexpr bool PERM = true, AFTER_DRAIN = false;
    bf16_t* T;
    __device__ __forceinline__ void operator()(const f32x4 (&acc)[2][2][4][2], const Unit& u, int wr, int wc, int fr, int fq) const {
        const int row0 = u.pm * 256 + wr * 64 + fr, col0 = u.pn * 256 + wc * 32 + 8 * fq;
#pragma unroll
        for (int ai = 0; ai < 2; ++ai)
#pragma unroll
            for (int m = 0; m < 4; ++m) { bf16_t* rowp = T + (size_t)(row0 + ai * 128 + m * 16) * 3072 + col0;
#pragma unroll
                for (int bj = 0; bj < 2; ++bj) { float v[8];
#pragma unroll
                    for (int i = 0; i < 4; ++i) { v[i] = acc[ai][bj][m][0][i]; v[4 + i] = acc[ai][bj][m][1][i]; }
#pragma unroll
                    for (int i = 0; i < 8; ++i) v[i] = fminf(__builtin_amdgcn_rcpf(1.0f + __expf(-v[i])), 1.0f);
                    *(u32x4*)(rowp + bj * 128) = pack8(v); } }
    }
};
struct GateOrder : pg8::StaticOrder {
    __device__ bool next(int i, Unit& u) const { const int ii = i / 3, br = i - 3 * ii; Unit t; if (!pg8::StaticOrder::next(ii, t)) return false; u.pm = t.pm; u.pn = t.pn + 4 * br; return true; }
};
struct EpiBranch {
    static constexpr bool PERM = true, AFTER_DRAIN = false;
    const bf16_t* T; bf16_t* MG; int first;
    __device__ __forceinline__ void operator()(const f32x4 (&acc)[2][2][4][2], const Unit& u, int wr, int wc, int fr, int fq) const {
        const int row0 = u.pm * 256 + wr * 64 + fr, col0 = u.pn * 256 + wc * 32 + 8 * fq;
#pragma unroll
        for (int ai = 0; ai < 2; ++ai)
#pragma unroll
            for (int m = 0; m < 4; ++m) { const size_t off = (size_t)(row0 + ai * 128 + m * 16) * 1024 + col0;
                u32x4 tg[2], tp[2];
                const size_t offg = (size_t)(row0 + ai * 128 + m * 16) * 3072 + col0;
#pragma unroll
                for (int bj = 0; bj < 2; ++bj) { tg[bj] = *(const u32x4*)(T + offg + bj * 128); tp[bj] = first ? (u32x4){0u, 0u, 0u, 0u} : *(const u32x4*)(MG + off + bj * 128); }
#pragma unroll
                for (int bj = 0; bj < 2; ++bj) { float v[8], g[8], p[8];
#pragma unroll
                    for (int i = 0; i < 4; ++i) { v[i] = acc[ai][bj][m][0][i]; v[4 + i] = acc[ai][bj][m][1][i]; }
                    unpack8(tg[bj], g); unpack8(tp[bj], p);
#pragma unroll
                    for (int i = 0; i < 8; ++i) v[i] = v[i] * g[i] + p[i];
                    *(u32x4*)(MG + off + bj * 128) = pack8(v); } }
    }
};

__device__ __forceinline__ float dpp_ror1(float x) { return __int_as_float(__builtin_amdgcn_update_dpp(0, __float_as_int(x), 0x121, 0xF, 0xF, false)); }
__device__ __forceinline__ float dpp_ror15(float x) { return __int_as_float(__builtin_amdgcn_update_dpp(0, __float_as_int(x), 0x12F, 0xF, 0xF, false)); }
struct EpiAct {
    static constexpr bool PERM = true, AFTER_DRAIN = false;
    bf16_t* ACT; bf16_t* SIDE; const float* cw; const float* cb;
    __device__ __forceinline__ void operator()(const f32x4 (&acc)[2][2][4][2], const Unit& u, int wr, int wc, int fr, int fq) const {
        const int c8 = u.pn * 128 + wc * 32 + 8 * fq;
        float w0[8], w1[8], w2[8], bs[8];
#pragma unroll
        for (int i = 0; i < 2; ++i) { const float4 a = *(const float4*)(cw + c8 + 4 * i), b = *(const float4*)(cw + DFF + c8 + 4 * i), d = *(const float4*)(cw + 2 * DFF + c8 + 4 * i), e = *(const float4*)(cb + c8 + 4 * i);
            w0[4 * i] = a.x; w0[4 * i + 1] = a.y; w0[4 * i + 2] = a.z; w0[4 * i + 3] = a.w; w1[4 * i] = b.x; w1[4 * i + 1] = b.y; w1[4 * i + 2] = b.z; w1[4 * i + 3] = b.w;
            w2[4 * i] = d.x; w2[4 * i + 1] = d.y; w2[4 * i + 2] = d.z; w2[4 * i + 3] = d.w; bs[4 * i] = e.x; bs[4 * i + 1] = e.y; bs[4 * i + 2] = e.z; bs[4 * i + 3] = e.w; }
        const bool f0 = (fr == 0), f15 = (fr == 15);
#pragma unroll
        for (int ai = 0; ai < 2; ++ai) { const int rb = u.pm * 256 + ai * 128 + wr * 64; bf16_t* sd = SIDE + (size_t)(rb >> 6) * 6 * 2816 + c8;
#pragma unroll
            for (int m = 0; m < 4; ++m) { float o[8], av[8], bv[8];
#pragma unroll
                for (int n = 0; n < 2; ++n)
#pragma unroll
                    for (int i = 0; i < 4; ++i) { const int q = 4 * n + i; const float a0 = acc[ai][0][m][n][i];
                        const float pa = dpp_ror1(a0), pb = dpp_ror1(acc[ai][0][m > 0 ? m - 1 : 0][n][i]);
                        const float na = dpp_ror15(a0), nb = dpp_ror15(acc[ai][0][m < 3 ? m + 1 : 3][n][i]);
                        const float am = f0 ? pb : pa, ap = f15 ? nb : na;
                        av[q] = a0; bv[q] = acc[ai][1][m][n][i]; o[q] = w0[q] * am + w1[q] * a0 + w2[q] * ap + bs[q]; }
#pragma unroll
                for (int q = 0; q < 8; q += 2) { const f32x2 gl = pg8::gelu_pk((f32x2){o[q], o[q + 1]}); o[q] = gl.x * bv[q]; o[q + 1] = gl.y * bv[q + 1]; }
                const bool edge = (m == 0 && f0) || (m == 3 && f15);
                if (!edge) *(u32x4*)(ACT + (size_t)(rb + 16 * m + fr) * 2816 + c8) = pack8(o);
                if (m == 0 && fr <= 1) { *(u32x4*)(sd + (size_t)fr * 2816) = pack8(av); if (f0) *(u32x4*)(sd + (size_t)4 * 2816) = pack8(bv); }
                if (m == 3 && fr >= 14) { *(u32x4*)(sd + (size_t)(fr - 12) * 2816) = pack8(av); if (f15) *(u32x4*)(sd + (size_t)5 * 2816) = pack8(bv); } } }
    }
};

struct Args { const float* in[29]; float* out; unsigned char* ws; int ph_lo, ph_hi; };
struct Ctx { float* out; unsigned char* ws; unsigned char* lds; int tid, lane, wave, G, bid; };

__device__ __forceinline__ void cvt_job(const Ctx& c, const float* src, int ld, int c0, int K, int N, bf16_t* dst, int& cnt, int il = 0, int boff = 0, int nblk = 0) {
    const int kt = K / 64, ntl = (N + 63) / 64, ntiles = kt * ntl, NW = (nblk ? nblk : c.G) * 8, gw = c.bid * 8 + c.wave;
    const int start = (gw + NW - (cnt % NW)) % NW; cnt += ntiles;
    if (nblk && c.bid >= nblk) return;
    for (int t = start; t < ntiles; t += NW) {
        const int k0 = (t % kt) * 64, n = (t / kt) * 64 + c.lane;
        if (n < N) { const float* sp = src + (size_t)k0 * ld + c0 + n; bf16_t* dp = dst + (size_t)(il ? ((n >> 7) * 256 + (n & 127) + boff) : n) * K + k0;
#pragma unroll 4
            for (int q = 0; q < 8; ++q) { float v[8];
#pragma unroll
                for (int i = 0; i < 8; ++i) v[i] = __builtin_nontemporal_load(sp + (size_t)(8 * q + i) * ld);
                *(u32x4*)(dp + 8 * q) = pack8(v); } }
    }
}
__device__ __forceinline__ void convert_mix_weights(const Ctx& c, int l, const float* w_in_all, const float* pool_w, const float* pool_scale, const float* wb0, const float* wb1, const float* wb2, const float* w_out) {
    int cnt = 0;
    const float* w_in = w_in_all + (size_t)l * D * DIN;
    bf16_t* Win = (bf16_t*)(c.ws + WS_WIN);
    cvt_job(c, w_in, DIN, 0, 1024, 3584, Win, cnt);
    cvt_job(c, w_in, DIN, C_LR, 1024, 32, Win + (size_t)4096 * 1024, cnt);
    cvt_job(c, w_in, DIN, C_GATE, 1024, 3072, (bf16_t*)(c.ws + WS_WG), cnt);
    cvt_job(c, wb0 + (size_t)l * 512 * 1024, 1024, 0, 512, 1024, (bf16_t*)(c.ws + WS_WBR), cnt);
    cvt_job(c, wb1 + (size_t)l * 512 * 1024, 1024, 0, 512, 1024, (bf16_t*)(c.ws + WS_WBR) + (size_t)1024 * 512, cnt);
    cvt_job(c, wb2 + (size_t)l * 512 * 1024, 1024, 0, 512, 1024, (bf16_t*)(c.ws + WS_WBR) + (size_t)2 * 1024 * 512, cnt);
    cvt_job(c, w_out + (size_t)l * 1024 * 1024, 1024, 0, 1024, 1024, (bf16_t*)(c.ws + WS_WOUT), cnt);
    const int gt = c.bid * 512 + c.tid, NT = c.G * 512;
    for (int i = gt; i < 224 * 1024 / 2; i += NT) ((unsigned*)(Win + (size_t)4128 * 1024))[i] = 0u;
    const float* pw = pool_w + (size_t)l * 4 * 128 * 128; const float* ps = pool_scale + (size_t)l * 512;
    for (int i = gt; i < 128 * 512; i += NT) { const int kb = (i >> 9) * 8, n = i & 511, g = n >> 7, nn = n & 127;
        const float* wr = w_in + (size_t)kb * DIN + C_POOL + g * 128; const float* pc = pw + (size_t)g * 128 * 128 + nn; float acc[8];
#pragma unroll
        for (int j = 0; j < 8; ++j) acc[j] = 0.f;
#pragma unroll 4
        for (int cc = 0; cc < 128; ++cc) { const float pv = pc[cc * 128];
#pragma unroll
            for (int j = 0; j < 8; ++j) acc[j] += wr[(size_t)j * DIN + cc] * pv; }
        float o[8]; const float sc = ps[n];
#pragma unroll
        for (int j = 0; j < 8; ++j) o[j] = acc[j] * sc;
        *(u32x4*)(Win + (size_t)(3584 + n) * 1024 + kb) = pack8(o); }
}
__device__ __forceinline__ void convert_wup(const Ctx& c, int l, const float* w_up, int nblk) {
    int cnt = 0;
    cvt_job(c, w_up + (size_t)l * 1024 * 5632, 5632, 0, 1024, 2816, (bf16_t*)(c.ws + WS_WUP), cnt, 1, 0, nblk);
    cvt_job(c, w_up + (size_t)l * 1024 * 5632, 5632, 2816, 1024, 2816, (bf16_t*)(c.ws + WS_WUP), cnt, 1, 128, nblk);
}
__device__ __forceinline__ void convert_wdn(const Ctx& c, int l, const float* w_dn) {
    int cnt = 0;
    cvt_job(c, w_dn + (size_t)l * 2816 * 1024, 1024, 0, 2816, 1024, (bf16_t*)(c.ws + WS_WDN), cnt);
}

__device__ __forceinline__ void rowwise(const Ctx& c, const float* xs32, const bf16_t* xs16, const bf16_t* y, const float* gpost, bf16_t* xd16, float* xd32_lo, float* xd32_hi, const float* gpre, bf16_t* hout) {
    const int gw = c.bid * 8 + c.wave, NGW = c.G * 8;
    float gq[16], gp[16];
#pragma unroll
    for (int i = 0; i < 2; ++i) {
#pragma unroll
        for (int j = 0; j < 8; ++j) { gq[8 * i + j] = y ? gpost[512 * i + 8 * c.lane + j] : 0.f; gp[8 * i + j] = gpre ? gpre[512 * i + 8 * c.lane + j] : 0.f; } }
    for (int row0 = gw; row0 < M; row0 += 2 * NGW) {
        float xv[2][16], yv[2][16]; const bool has1 = (row0 + NGW < M);
#pragma unroll
        for (int u = 0; u < 2; ++u) { const int row = (u == 0 || has1) ? row0 + u * NGW : row0;
#pragma unroll
            for (int i = 0; i < 2; ++i) {
                if (xs32) { const float4* p = (const float4*)(xs32 + (size_t)row * D + 512 * i + 8 * c.lane); const float4 a = p[0], b = p[1];
                    xv[u][8 * i] = a.x; xv[u][8 * i + 1] = a.y; xv[u][8 * i + 2] = a.z; xv[u][8 * i + 3] = a.w; xv[u][8 * i + 4] = b.x; xv[u][8 * i + 5] = b.y; xv[u][8 * i + 6] = b.z; xv[u][8 * i + 7] = b.w; }
                else unpack8(*(const u32x4*)(xs16 + (size_t)row * D + 512 * i + 8 * c.lane), xv[u] + 8 * i);
                if (y) unpack8(*(const u32x4*)(y + (size_t)row * D + 512 * i + 8 * c.lane), yv[u] + 8 * i); } }
#pragma unroll
        for (int u = 0; u < 2; ++u) { if (u == 1 && !has1) break; const int row = row0 + u * NGW;
            if (y) { float ss = 0.f;
#pragma unroll
                for (int i = 0; i < 16; ++i) ss += yv[u][i] * yv[u][i];
                ss = wave_sum(ss); const float r = rsqrtf(ss * (1.0f / D) + EPS);
#pragma unroll
                for (int i = 0; i < 16; ++i) xv[u][i] += yv[u][i] * r * gq[i]; }
            if (xd16) {
#pragma unroll
                for (int i = 0; i < 2; ++i) *(u32x4*)(xd16 + (size_t)row * D + 512 * i + 8 * c.lane) = pack8(xv[u] + 8 * i); }
            else { float* dst = (row < M / 2) ? xd32_lo + (size_t)row * D : xd32_hi + (size_t)(row - M / 2) * D;
#pragma unroll
                for (int i = 0; i < 2; ++i) { float4* p = (float4*)(dst + 512 * i + 8 * c.lane);
                    p[0] = make_float4(xv[u][8 * i], xv[u][8 * i + 1], xv[u][8 * i + 2], xv[u][8 * i + 3]); p[1] = make_float4(xv[u][8 * i + 4], xv[u][8 * i + 5], xv[u][8 * i + 6], xv[u][8 * i + 7]); } }
            if (gpre) { float ss = 0.f;
#pragma unroll
                for (int i = 0; i < 16; ++i) ss += xv[u][i] * xv[u][i];
                ss = wave_sum(ss); const float r = rsqrtf(ss * (1.0f / D) + EPS);
#pragma unroll
                for (int i = 0; i < 2; ++i) { float hv[8];
#pragma unroll
                    for (int j = 0; j < 8; ++j) hv[j] = xv[u][8 * i + j] * r * gp[8 * i + j];
                    *(u32x4*)(hout + (size_t)row * D + 512 * i + 8 * c.lane) = pack8(hv); } } }
    }
}

__device__ __forceinline__ void hyena_hidden(const Ctx& c, const float* W1, const float* B1, const float* F1, const float* W2, const float* B2, const float* F2) {
    float* HID = (float*)(c.ws + WS_HID);
    const int gw = c.bid * 8 + c.wave, NGW = c.G * 8, j = c.lane;
    for (int it = gw; it < DEPTH * L; it += NGW) { const int l = it >> 12, t = it & 4095;
        const float* w1 = W1 + (size_t)l * 33 * 64; const float* b1 = B1 + l * 64; const float* f1 = F1 + l * 64;
        const float* w2 = W2 + (size_t)l * 64 * 64; const float* b2 = B2 + l * 64; const float* f2 = F2 + l * 64;
        float z = 0.f;
        { const float wt = 6.283185307179586f * (float)t / (float)L;
          if (j == 0) z = (float)t / (float)(L - 1);
          else if (j <= 32) { const int bi = (j - 1) & 15; const float f = 1e-4f + (float)bi * ((15.0f - 1e-4f) / 15.0f); const float ang = f * wt; z = (j <= 16) ? cosf(ang) : -sinf(ang); } }
        float s = b1[j];
        for (int e = 0; e < 33; ++e) s += __shfl(z, e) * w1[e * 64 + j];
        const float h1 = sinf(f1[j] * s);
        float s2 = b2[j];
        for (int i = 0; i < 64; ++i) s2 += __shfl(h1, i) * w2[i * 64 + j];
        HID[(size_t)it * 64 + j] = sinf(f2[j] * s2);
    }
    float2* TW8 = (float2*)(c.ws + WS_TW8);
    for (int k = c.bid * 512 + c.tid; k < 4096; k += c.G * 512) { float sn, cs; sincospif((float)k * (1.0f / 4096.0f), &sn, &cs); TW8[k] = make_float2(cs, -sn); }
}

__device__ __forceinline__ void hyena_taps(const Ctx& c, int l, const float* W3, int blk0, int nblk) {
    const float* HID = (const float*)(c.ws + WS_HID) + (size_t)l * L * 64; const float* w3 = W3 + (size_t)l * 64 * 1024; float* TAPS = (float*)(c.ws + WS_TAPS);
    float* hs = (float*)c.lds + c.wave * 1024;
    const int gw = (c.bid - blk0) * 8 + c.wave, NGW = nblk * 8;
    if (c.bid >= blk0 && c.bid < blk0 + nblk) for (int it = gw; it < 256 * 4; it += NGW) { const int t0 = (it >> 2) * 16, c0 = (it & 3) * 256 + 4 * c.lane;
#pragma unroll
        for (int q = 0; q < 4; ++q) *(float4*)(hs + q * 256 + 4 * c.lane) = *(const float4*)(HID + (size_t)t0 * 64 + q * 256 + 4 * c.lane);
        float acc[16][4];
#pragma unroll
        for (int r = 0; r < 16; ++r) { acc[r][0] = 0.f; acc[r][1] = 0.f; acc[r][2] = 0.f; acc[r][3] = 0.f; }
#pragma unroll 2
        for (int j0 = 0; j0 < 64; j0 += 4) { float4 wv[4];
#pragma unroll
            for (int q = 0; q < 4; ++q) wv[q] = *(const float4*)(w3 + (size_t)(j0 + q) * 1024 + c0);
#pragma unroll
            for (int r = 0; r < 16; ++r) { const float4 hv = *(const float4*)(hs + r * 64 + j0);
                acc[r][0] += hv.x * wv[0].x + hv.y * wv[1].x + hv.z * wv[2].x + hv.w * wv[3].x; acc[r][1] += hv.x * wv[0].y + hv.y * wv[1].y + hv.z * wv[2].y + hv.w * wv[3].y;
                acc[r][2] += hv.x * wv[0].z + hv.y * wv[1].z + hv.z * wv[2].z + hv.w * wv[3].z; acc[r][3] += hv.x * wv[0].w + hv.y * wv[1].w + hv.z * wv[2].w + hv.w * wv[3].w; } }
#pragma unroll
        for (int cc = 0; cc < 4; ++cc) { float4* o = (float4*)(TAPS + (size_t)(c0 + cc) * 4096 + t0);
#pragma unroll
            for (int q = 0; q < 4; ++q) o[q] = make_float4(acc[4 * q][cc], acc[4 * q + 1][cc], acc[4 * q + 2][cc], acc[4 * q + 3][cc]); }
    }
    __syncthreads();
}

__device__ __forceinline__ float2 cmul(float2 a, float2 b) { float x = a.x * b.x - a.y * b.y; const float y = a.x * b.y + a.y * b.x; asm("" : "+v"(x)); return make_float2(x, y); }
__device__ __forceinline__ float2 cmulc(float2 a, float2 b) { float x = a.x * b.x + a.y * b.y; const float y = a.y * b.x - a.x * b.y; asm("" : "+v"(x)); return make_float2(x, y); }
__device__ __forceinline__ float2 cadd(float2 a, float2 b) { float x = a.x + b.x; const float y = a.y + b.y; asm("" : "+v"(x)); return make_float2(x, y); }
__device__ __forceinline__ float2 csub(float2 a, float2 b) { float x = a.x - b.x; const float y = a.y - b.y; asm("" : "+v"(x)); return make_float2(x, y); }
#define XP(i) ((i) + ((i) >> 5))
__device__ __forceinline__ void fft_fwd(float2* X, const float2* TW, int tid, const float2* Kmul = nullptr) {
    const float RS = 0.70710678118654752f;
#pragma unroll 1
    for (int lh = 9; lh >= 0; lh -= 3) { const int h = 1 << lh, j = tid & (h - 1), i = ((tid >> lh) << (lh + 3)) + j;
        float2 x[8];
#pragma unroll
        for (int k = 0; k < 8; ++k) x[k] = X[XP(i + k * h)];
        const float2 w = TW[j << (9 - lh)], w2 = cmul(w, w), w4 = cmul(w2, w2), w2b = make_float2(w2.y, -w2.x);
        const float2 wa1 = make_float2(RS * (w.x + w.y), RS * (w.y - w.x)), wa2 = make_float2(w.y, -w.x), wa3 = make_float2(RS * (w.y - w.x), -RS * (w.x + w.y));
        const float2 u0 = cadd(x[0], x[4]), u1 = cadd(x[1], x[5]), u2 = cadd(x[2], x[6]), u3 = cadd(x[3], x[7]);
        const float2 v0 = cmul(csub(x[0], x[4]), w), v1 = cmul(csub(x[1], x[5]), wa1), v2 = cmul(csub(x[2], x[6]), wa2), v3 = cmul(csub(x[3], x[7]), wa3);
        const float2 p0 = cadd(u0, u2), q0 = cmul(csub(u0, u2), w2), p1 = cadd(u1, u3), q1 = cmul(csub(u1, u3), w2b);
        const float2 r0 = cadd(v0, v2), s0 = cmul(csub(v0, v2), w2), r1 = cadd(v1, v3), s1 = cmul(csub(v1, v3), w2b);
        float2 o[8] = {cadd(p0, p1), cmul(csub(p0, p1), w4), cadd(q0, q1), cmul(csub(q0, q1), w4), cadd(r0, r1), cmul(csub(r0, r1), w4), cadd(s0, s1), cmul(csub(s0, s1), w4)};
        if (Kmul && lh == 0) {
#pragma unroll
            for (int k = 0; k < 8; ++k) o[k] = cmul(o[k], Kmul[i + k]); }
#pragma unroll
        for (int k = 0; k < 8; ++k) X[XP(i + k * h)] = o[k];
        __syncthreads(); }
}
__device__ __forceinline__ void fft_inv(float2* X, const float2* TW, int tid) {
    const float RS = 0.70710678118654752f;
#pragma unroll 1
    for (int lh = 0; lh <= 9; lh += 3) { const int h = 1 << lh, j = tid & (h - 1), i = ((tid >> lh) << (lh + 3)) + j;
        float2 y[8];
#pragma unroll
        for (int k = 0; k < 8; ++k) y[k] = X[XP(i + k * h)];
        const float2 w = TW[j << (9 - lh)], w2 = cmul(w, w), w4 = cmul(w2, w2), w2b = make_float2(w2.y, -w2.x);
        const float2 wa1 = make_float2(RS * (w.x + w.y), RS * (w.y - w.x)), wa2 = make_float2(w.y, -w.x), wa3 = make_float2(RS * (w.y - w.x), -RS * (w.x + w.y));
        const float2 t1 = cmulc(y[1], w4), t3 = cmulc(y[3], w4), t5 = cmulc(y[5], w4), t7 = cmulc(y[7], w4);
        const float2 p0 = cadd(y[0], t1), p1 = csub(y[0], t1), q0 = cadd(y[2], t3), q1 = csub(y[2], t3), r0 = cadd(y[4], t5), r1 = csub(y[4], t5), s0 = cadd(y[6], t7), s1 = csub(y[6], t7);
        const float2 a0 = cmulc(q0, w2), a1 = cmulc(q1, w2b), b0 = cmulc(s0, w2), b1 = cmulc(s1, w2b);
        const float2 u0 = cadd(p0, a0), u2 = csub(p0, a0), u1 = cadd(p1, a1), u3 = csub(p1, a1), v0 = cadd(r0, b0), v2 = csub(r0, b0), v1 = cadd(r1, b1), v3 = csub(r1, b1);
        const float2 c0 = cmulc(v0, w), c1 = cmulc(v1, wa1), c2 = cmulc(v2, wa2), c3 = cmulc(v3, wa3);
        X[XP(i)] = cadd(u0, c0); X[XP(i + 4 * h)] = csub(u0, c0); X[XP(i + h)] = cadd(u1, c1); X[XP(i + 5 * h)] = csub(u1, c1);
        X[XP(i + 2 * h)] = cadd(u2, c2); X[XP(i + 6 * h)] = csub(u2, c2); X[XP(i + 3 * h)] = cadd(u3, c3); X[XP(i + 7 * h)] = csub(u3, c3);
        __syncthreads(); }
}
struct RowSeg { u32x4 m; unsigned lr; };
__device__ __forceinline__ RowSeg row_fetch(const bf16_t* p, int i0) {
    RowSeg r; r.m = *(const u32x4*)(p + i0);
    const unsigned lft = (i0 > 0) ? (unsigned)p[i0 - 1] : 0u, rgt = (i0 + 8 < L) ? (unsigned)p[i0 + 8] : 0u; r.lr = lft | (rgt << 16); return r; }
__device__ __forceinline__ void conv3_seg(const RowSeg& r, float w0, float w1, float w2, float bias, float* out) {
    float v[10]; unpack8(r.m, v + 1); v[0] = bflo(r.lr); v[9] = bfhi(r.lr);
#pragma unroll
    for (int q = 0; q < 8; ++q) out[q] = w0 * v[q] + w1 * v[q + 1] + w2 * v[q + 2] + bias;
}
__device__ __forceinline__ void fft_item(const Ctx& c, int l, int ch, const float* W3, const float* CW, const float* CB, const float* HB) {
    float2* TW = (float2*)c.lds; float2* X = TW + 2048; float2* KEs = X + 4224; float2* KOs = KEs + 4096;
    const float2* TW8 = (const float2*)(c.ws + WS_TW8);
    const int tid = c.tid;
    { const float dmin = -3.0701134573253944f, dmax = -15.350567286626973f;
      const float delta = fabsf(dmin + (dmax - dmin) * (float)ch / 511.0f);
      const float* tf = (const float*)(c.ws + WS_TAPS) + (size_t)ch * 4096; const float* tb = tf + (size_t)512 * 4096;
#pragma unroll
      for (int q = 0; q < 8; ++q) { const int i = tid + 512 * q;
          const float sf = tf[i] * __expf(-((float)i / 4095.0f) * delta);
          const int tbi = (i >= 1) ? L - i : 1; const float sb = (i >= 1) ? tb[tbi] * __expf(-((float)tbi / 4095.0f) * delta) : 0.f;
          const float2 w = TW8[i]; const float ov = sf - sb;
          X[XP(i)] = make_float2(sf + sb, 0.f); KOs[i] = make_float2(ov * w.x, ov * w.y); }
      __syncthreads(); fft_fwd(X, TW, tid);
#pragma unroll
      for (int q = 0; q < 8; ++q) { const int i = tid + 512 * q; KEs[i] = X[XP(i)]; X[XP(i)] = KOs[i]; }
      __syncthreads(); fft_fwd(X, TW, tid);
#pragma unroll
      for (int q = 0; q < 8; ++q) KOs[tid + 512 * q] = X[XP(tid + 512 * q)];
      __syncthreads(); }
    const float* cw = CW + (size_t)l * 3 * 1536; const float* cb = CB + (size_t)l * 1536;
    const float hb = (HB + (size_t)l * 512)[ch];
    bf16_t* UT = (bf16_t*)(c.ws + WS_UT);
    const int i0 = tid * 8;
    RowSeg rs[2][3];
#pragma unroll
    for (int bb = 0; bb < 2; ++bb)
#pragma unroll
        for (int r = 0; r < 3; ++r) rs[bb][r] = row_fetch(UT + ((size_t)bb * 1536 + r * 512 + ch) * 4096, i0);
#pragma unroll 1
    for (int p = 0; p < 4; ++p) {
        float zv[2][8], x0c[2][8];
#pragma unroll
        for (int bb = 0; bb < 2; ++bb) { float x1c[8], vc[8];
            conv3_seg(rs[bb][0], cw[ch], cw[1536 + ch], cw[3072 + ch], cb[ch], x0c[bb]);
            conv3_seg(rs[bb][1], cw[512 + ch], cw[1536 + 512 + ch], cw[3072 + 512 + ch], cb[512 + ch], x1c);
            conv3_seg(rs[bb][2], cw[1024 + ch], cw[1536 + 1024 + ch], cw[3072 + 1024 + ch], cb[1024 + ch], vc);
#pragma unroll
            for (int q = 0; q < 8; ++q) zv[bb][q] = x1c[q] * vc[q]; }
        float2 A[8];
#pragma unroll
        for (int q = 0; q < 8; ++q) X[XP(i0 + q)] = make_float2(zv[0][q], zv[1][q]);
        __syncthreads(); fft_fwd(X, TW, tid, KEs); fft_inv(X, TW, tid);
#pragma unroll
        for (int q = 0; q < 8; ++q) A[q] = X[XP(i0 + q)];
        __syncthreads();
#pragma unroll
        for (int q = 0; q < 8; ++q) X[XP(i0 + q)] = cmul(make_float2(zv[0][q], zv[1][q]), TW8[i0 + q]);
        __syncthreads(); fft_fwd(X, TW, tid, KOs);
        if (p < 3) {
#pragma unroll
            for (int bb = 0; bb < 2; ++bb)
#pragma unroll
                for (int r = 0; r < 3; ++r) rs[bb][r] = row_fetch(UT + ((size_t)(2 * p + 2 + bb) * 1536 + r * 512 + ch) * 4096, i0); }
        fft_inv(X, TW, tid);
        float o0[8], o1[8];
#pragma unroll
        for (int q = 0; q < 8; ++q) { float2 w = TW8[i0 + q]; w.y = -w.y; const float2 bq = cmul(X[XP(i0 + q)], w);
            const float yr = (A[q].x + bq.x) * (1.0f / 8192.0f), yi = (A[q].y + bq.y) * (1.0f / 8192.0f);
            o0[q] = x0c[0][q] * (yr + zv[0][q] * hb); o1[q] = x0c[1][q] * (yi + zv[1][q] * hb); }
        *(u32x4*)(UT + ((size_t)(2 * p) * 1536 + ch) * 4096 + i0) = pack8(o0);
        *(u32x4*)(UT + ((size_t)(2 * p + 1) * 1536 + ch) * 4096 + i0) = pack8(o1);
        __syncthreads();
    }
}

__device__ __forceinline__ void gla_item(const Ctx& c, int l, int it, const float* GW2, const float* GB) {
    const int tid = c.tid, lane = c.lane, w = c.wave;
    const int slice = it & 1, dir = (it >> 1) & 1, h = (it >> 2) & 3, b = it >> 4;
    constexpr int BS = 129;
    float* Bc = (float*)c.lds;
    bf16_t* QE = (bf16_t*)(c.lds + 33792);
    bf16_t* KE = QE + 64 * 136;
    bf16_t* KDT = KE + 64 * 136;
    bf16_t* VT = KDT + 128 * 72;
    bf16_t* P = VT + 64 * 72;
    bf16_t* ST = P + 64 * 72;
    float* EBL = (float*)(ST + 64 * 136);
    const bf16_t* QKVG = (const bf16_t*)(c.ws + WS_QKVG); const bf16_t* LRB = (const bf16_t*)(c.ws + WS_LR);
    bf16_t* Od = (bf16_t*)(c.ws + (dir ? WS_OB : WS_YGLA));
    const float* gw2 = GW2 + (size_t)l * 2 * 16 * 512; const float* gb = GB + (size_t)l * 2 * 512;
    const int lr_ = lane & 15, lq = lane >> 4;
    bf16x8 w2f = (bf16x8){0, 0, 0, 0, 0, 0, 0, 0};
    if (lq < 2) {
#pragma unroll
        for (int i = 0; i < 8; ++i) w2f[i] = (short)f2bf(gw2[(size_t)(dir * 16 + lq * 8 + i) * 512 + h * 128 + 16 * w + lr_]); }
    const float gbias = gb[dir * 512 + h * 128 + 16 * w + lr_];
    f32x4 S[4]; S[0] = (f32x4){0.f, 0.f, 0.f, 0.f}; S[1] = S[0]; S[2] = S[0]; S[3] = S[0];
    for (int i = tid; i < 64 * 136 / 2; i += 512) ((unsigned*)ST)[i] = 0u;
    const int j8 = tid >> 3, e8 = (tid & 7) * 8, d0 = 16 * w;
    u32x4 lrf[4]; u32x4 vv; u32x4 qv[2], kv[2];
    { const int n = dir ? 63 : 0; const size_t rbase = (size_t)b * L + (size_t)n * 64;
      const size_t row8 = rbase + (dir ? 63 - j8 : j8), rowl = rbase + (dir ? 63 - lane : lane);
#pragma unroll
      for (int jt = 0; jt < 4; ++jt) { const int j = jt * 16 + lr_; lrf[jt] = (lq < 2) ? *(const u32x4*)(LRB + (rbase + (dir ? 63 - j : j)) * 32 + dir * 16 + lq * 8) : (u32x4){0u, 0u, 0u, 0u}; }
      vv = *(const u32x4*)(QKVG + row8 * 2048 + 1024 + h * 128 + slice * 64 + e8);
      const u32x4* qp = (const u32x4*)(QKVG + rowl * 2048 + h * 128 + d0); qv[0] = qp[0]; qv[1] = qp[1];
      const u32x4* kp = (const u32x4*)(QKVG + rowl * 2048 + 512 + h * 128 + d0); kv[0] = kp[0]; kv[1] = kp[1]; }
#pragma unroll 1
    for (int nn = 0; nn < 64; ++nn) {
        const int n = dir ? 63 - nn : nn;
        const size_t rbase = (size_t)b * L + (size_t)n * 64;
        VT[(e8 + 0) * 72 + j8] = (bf16_t)(vv.x & 0xffffu); VT[(e8 + 1) * 72 + j8] = (bf16_t)(vv.x >> 16); VT[(e8 + 2) * 72 + j8] = (bf16_t)(vv.y & 0xffffu); VT[(e8 + 3) * 72 + j8] = (bf16_t)(vv.y >> 16);
        VT[(e8 + 4) * 72 + j8] = (bf16_t)(vv.z & 0xffffu); VT[(e8 + 5) * 72 + j8] = (bf16_t)(vv.z >> 16); VT[(e8 + 6) * 72 + j8] = (bf16_t)(vv.w & 0xffffu); VT[(e8 + 7) * 72 + j8] = (bf16_t)(vv.w >> 16);
        const u32x4 q0 = qv[0], q1 = qv[1], k0 = kv[0], k1 = kv[1], l0 = lrf[0], l1 = lrf[1], l2 = lrf[2], l3 = lrf[3];
        if (nn < 63) { const int n2 = dir ? 62 - nn : nn + 1; const size_t rb2 = (size_t)b * L + (size_t)n2 * 64;
            const size_t row8 = rb2 + (dir ? 63 - j8 : j8), rowl = rb2 + (dir ? 63 - lane : lane);
#pragma unroll
            for (int jt = 0; jt < 4; ++jt) { const int j = jt * 16 + lr_; lrf[jt] = (lq < 2) ? *(const u32x4*)(LRB + (rb2 + (dir ? 63 - j : j)) * 32 + dir * 16 + lq * 8) : (u32x4){0u, 0u, 0u, 0u}; }
            vv = *(const u32x4*)(QKVG + row8 * 2048 + 1024 + h * 128 + slice * 64 + e8);
            const u32x4* qp = (const u32x4*)(QKVG + rowl * 2048 + h * 128 + d0); qv[0] = qp[0]; qv[1] = qp[1];
            const u32x4* kp = (const u32x4*)(QKVG + rowl * 2048 + 512 + h * 128 + d0); kv[0] = kp[0]; kv[1] = kp[1]; }
        { const u32x4 lfr[4] = {l0, l1, l2, l3}; float base = 0.f;
#pragma unroll
          for (int jt = 0; jt < 4; ++jt) { f32x4 g = (f32x4){gbias, gbias, gbias, gbias};
              bf16x8 a; { union { u32x4 u; bf16x8 v; } cv; cv.u = lfr[jt]; a = cv.v; }
              g = __builtin_amdgcn_mfma_f32_16x16x32_bf16(a, w2f, g, 0, 0, 0);
              float cs[4]; float run = 0.f;
#pragma unroll
              for (int r = 0; r < 4; ++r) { const float gk = g[r]; const float ls = fminf(gk, 0.f) - 0.69314718056f * __builtin_amdgcn_logf(1.0f + __builtin_amdgcn_exp2f(-1.44269504089f * fabsf(gk))); run += fmaxf(ls * (1.0f / 16.0f), -1.0f); cs[r] = run; }
              const float x1 = __shfl_up(run, 16), x2 = __shfl_up(run, 32), x3 = __shfl_up(run, 48);
              const float excl = (lq >= 1 ? x1 : 0.f) + (lq >= 2 ? x2 : 0.f) + (lq >= 3 ? x3 : 0.f);
              const float tot = __shfl(excl + run, 48 + lr_);
#pragma unroll
              for (int r = 0; r < 4; ++r) Bc[(jt * 16 + lq * 4 + r) * BS + 16 * w + lr_] = base + excl + cs[r];
              base += tot; }
          if (lq == 0) EBL[16 * w + lr_] = __builtin_amdgcn_exp2f(1.44269504089f * base); }
        __syncthreads();
        { float qe[16], ke[16], q[16], k[16]; unpack8(q0, q); unpack8(q1, q + 8); unpack8(k0, k); unpack8(k1, k + 8);
#pragma unroll
          for (int i = 0; i < 16; ++i) { const int d = d0 + i; const float e1 = __builtin_amdgcn_exp2f(1.44269504089f * Bc[lane * BS + d]), e2 = __builtin_amdgcn_rcpf(e1);
              qe[i] = q[i] * 0.08838834764831845f * e1; ke[i] = k[i] * e2;
              KDT[d * 72 + lane] = f2bf(k[i] * e2 * EBL[d]); }
          *(u32x4*)(QE + lane * 136 + d0) = pack8(qe); *(u32x4*)(QE + lane * 136 + d0 + 8) = pack8(qe + 8);
          *(u32x4*)(KE + lane * 136 + d0) = pack8(ke); *(u32x4*)(KE + lane * 136 + d0 + 8) = pack8(ke + 8); }
        __syncthreads();
#pragma unroll
        for (int i = 0; i < 2; ++i) { const int tile = 2 * w + i, jt = tile >> 2, st = tile & 3;
            f32x4 acc = (f32x4){0.f, 0.f, 0.f, 0.f};
            if (st <= jt) {
#pragma unroll
                for (int kk = 0; kk < 4; ++kk) { const bf16x8 a = *(const bf16x8*)(QE + (jt * 16 + lr_) * 136 + kk * 32 + lq * 8);
                    const bf16x8 bv = *(const bf16x8*)(KE + (st * 16 + lr_) * 136 + kk * 32 + lq * 8);
                    acc = __builtin_amdgcn_mfma_f32_16x16x32_bf16(a, bv, acc, 0, 0, 0); } }
#pragma unroll
            for (int r = 0; r < 4; ++r) { const int j = jt * 16 + lq * 4 + r, s = st * 16 + lr_; const bool keep = dir ? (s < j) : (s <= j);
                P[j * 72 + s] = f2bf(keep ? acc[r] : 0.f); } }
        __syncthreads();
#pragma unroll
        for (int eh = 0; eh < 2; ++eh) { const int jt = w >> 1, et = 2 * (w & 1) + eh; f32x4 acc = (f32x4){0.f, 0.f, 0.f, 0.f};
#pragma unroll
          for (int kk = 0; kk < 2; ++kk) { const bf16x8 a = *(const bf16x8*)(P + (jt * 16 + lr_) * 72 + kk * 32 + lq * 8);
              const bf16x8 bv = *(const bf16x8*)(VT + (et * 16 + lr_) * 72 + kk * 32 + lq * 8);
              acc = __builtin_amdgcn_mfma_f32_16x16x32_bf16(a, bv, acc, 0, 0, 0); }
#pragma unroll
          for (int kk = 0; kk < 4; ++kk) { const bf16x8 a = *(const bf16x8*)(QE + (jt * 16 + lr_) * 136 + kk * 32 + lq * 8);
              const bf16x8 bv = *(const bf16x8*)(ST + (et * 16 + lr_) * 136 + kk * 32 + lq * 8);
              acc = __builtin_amdgcn_mfma_f32_16x16x32_bf16(a, bv, acc, 0, 0, 0); }
#pragma unroll
          for (int r = 0; r < 4; ++r) { const int j = jt * 16 + lq * 4 + r, e = et * 16 + lr_; const size_t row = rbase + (dir ? 63 - j : j);
              Od[row * 512 + h * 128 + slice * 64 + e] = f2bf(acc[r]); } }
#pragma unroll
        for (int et = 0; et < 4; ++et) { f32x4 acc;
#pragma unroll
            for (int r = 0; r < 4; ++r) acc[r] = S[et][r] * EBL[16 * w + lq * 4 + r];
#pragma unroll
            for (int kk = 0; kk < 2; ++kk) { const bf16x8 a = *(const bf16x8*)(KDT + (16 * w + lr_) * 72 + kk * 32 + lq * 8);
                const bf16x8 bv = *(const bf16x8*)(VT + (et * 16 + lr_) * 72 + kk * 32 + lq * 8);
                acc = __builtin_amdgcn_mfma_f32_16x16x32_bf16(a, bv, acc, 0, 0, 0); }
            S[et] = acc; }
        __syncthreads();
#pragma unroll
        for (int et = 0; et < 4; ++et) { u32x2 wv; wv.x = (unsigned)f2bf(S[et][0]) | ((unsigned)f2bf(S[et][1]) << 16); wv.y = (unsigned)f2bf(S[et][2]) | ((unsigned)f2bf(S[et][3]) << 16);
            *(u32x2*)(ST + (et * 16 + lr_) * 136 + 16 * w + lq * 4) = wv; }
    }
    __syncthreads();
}

template <int W>
__device__ __forceinline__ void pool_item(const bf16_t* PB, bf16_t* Y, int row, int c8) {
    const int t = row & 4095, lo = t - W / 2; float s[8], x[8]; u32x4 v[W];
#pragma unroll
    for (int i = 0; i < W; ++i) { const int tt = lo + i; const int tc = min(max(tt, 0), L - 1); v[i] = *(const u32x4*)(PB + (size_t)(row - t + tc) * 512 + c8); }
#pragma unroll
    for (int j = 0; j < 8; ++j) s[j] = 0.f;
#pragma unroll
    for (int i = 0; i < W; ++i) { const int tt = lo + i; const float m = (tt >= 0 && tt < L) ? 1.0f : 0.0f; float f[8]; unpack8(v[i], f);
#pragma unroll
        for (int j = 0; j < 8; ++j) s[j] += m * f[j]; }
    unpack8(v[W / 2], x);
    const float inv = 1.0f / (float)(min(t + W / 2, L) - max(t - W / 2, 0));
#pragma unroll
    for (int j = 0; j < 8; ++j) s[j] = s[j] * inv - x[j];
    *(u32x4*)(Y + (size_t)row * 512 + c8) = pack8(s);
}
__device__ __forceinline__ void pool_stencil(const Ctx& c, int nblk) {
    const bf16_t* PB = (const bf16_t*)(c.ws + WS_POOL); bf16_t* Y = (bf16_t*)(c.ws + WS_YPOOL);
    const int gw = c.bid * 8 + c.wave, NGW = nblk * 8, r4 = c.lane >> 4, ch = (c.lane & 15) * 8;
    if (c.bid >= nblk) return;
    for (int it = gw; it < (M / 4) * 4; it += NGW) { const int g = it & 3, row = (it >> 2) * 4 + r4, c8 = g * 128 + ch;
        if (g == 0) pool_item<2>(PB, Y, row, c8); else if (g == 1) pool_item<4>(PB, Y, row, c8); else if (g == 2) pool_item<8>(PB, Y, row, c8); else pool_item<16>(PB, Y, row, c8); }
}
__device__ __forceinline__ void post_phase(const Ctx& c, int l, const float* GN) {
    const bf16_t* UT = (const bf16_t*)(c.ws + WS_UT); bf16_t* YH = (bf16_t*)(c.ws + WS_YHY);
    { const int qd = c.tid >> 7, tq = c.tid & 127; bf16_t* T = (bf16_t*)c.lds + qd * (64 * 72);
      for (int tile0 = c.bid * 4; tile0 < NB * 8 * 64; tile0 += c.G * 4) { const int tile = tile0 + qd, b = tile >> 9, c0 = ((tile >> 6) & 7) * 64, t0 = (tile & 63) * 64;
#pragma unroll
          for (int hh = 0; hh < 4; ++hh) { const int cc = (tq >> 3) + 16 * hh, t8 = (tq & 7) * 8; *(u32x4*)(T + cc * 72 + t8) = *(const u32x4*)(UT + ((size_t)b * 1536 + c0 + cc) * 4096 + t0 + t8); }
          __syncthreads();
#pragma unroll
          for (int hh = 0; hh < 4; ++hh) { const int tt = (tq >> 3) + 16 * hh, c8 = (tq & 7) * 8; unsigned wv[4];
#pragma unroll
              for (int i = 0; i < 4; ++i) wv[i] = (unsigned)T[(c8 + 2 * i) * 72 + tt] | ((unsigned)T[(c8 + 2 * i + 1) * 72 + tt] << 16);
              u32x4 o; o.x = wv[0]; o.y = wv[1]; o.z = wv[2]; o.w = wv[3];
              *(u32x4*)(YH + ((size_t)b * 4096 + t0 + tt) * 512 + c0 + c8) = o; }
          __syncthreads(); } }
    bf16_t* YG = (bf16_t*)(c.ws + WS_YGLA); const bf16_t* OB = (const bf16_t*)(c.ws + WS_OB); const bf16_t* QKVG = (const bf16_t*)(c.ws + WS_QKVG);
    const float* gn = GN + (size_t)l * 128;
    float gnv[8];
#pragma unroll
    for (int i = 0; i < 8; ++i) gnv[i] = gn[(c.lane & 15) * 8 + i];
    const int NGW = c.G * 8;
    for (int row0 = c.bid * 8 + c.wave; row0 < M; row0 += 2 * NGW) { u32x4 ra[2], rb[2], rg[2];
#pragma unroll
        for (int u = 0; u < 2; ++u) { const int row = (row0 + u * NGW < M) ? row0 + u * NGW : row0;
            ra[u] = *(const u32x4*)(YG + (size_t)row * 512 + c.lane * 8); rb[u] = *(const u32x4*)(OB + (size_t)row * 512 + c.lane * 8); rg[u] = *(const u32x4*)(QKVG + (size_t)row * 2048 + 1536 + c.lane * 8); }
#pragma unroll
        for (int u = 0; u < 2; ++u) { const int row = row0 + u * NGW; if (row >= M) break;
            float a[8], bq[8], g[8]; unpack8(ra[u], a); unpack8(rb[u], bq); unpack8(rg[u], g);
            float ss = 0.f;
#pragma unroll
            for (int i = 0; i < 8; ++i) { a[i] += bq[i]; ss += a[i] * a[i]; }
#pragma unroll
            for (int o = 8; o; o >>= 1) ss += __shfl_xor(ss, o);
            const float r = rsqrtf(ss * (1.0f / 128.0f) + EPS);
#pragma unroll
            for (int i = 0; i < 8; ++i) a[i] = a[i] * r * gnv[i] * g[i] * __builtin_amdgcn_rcpf(1.0f + __expf(-g[i]));
            *(u32x4*)(YG + (size_t)row * 512 + c.lane * 8) = pack8(a); } }
}
__device__ __forceinline__ void act_fixup(const Ctx& c, int l, int pm, const float* CW, const float* CB) {
    bf16_t* ACT = (bf16_t*)(c.ws + WS_ACT); const bf16_t* SIDE = (const bf16_t*)(c.ws + WS_SIDE); const float* cw = CW + (size_t)l * 3 * DFF; const float* cb = CB + (size_t)l * DFF;
    for (int idx = c.tid; idx < 4 * 2 * 352; idx += 512) { const int bl = idx / 704, blk = 4 * pm + bl, rem = idx - bl * 704, e = rem / 352, ch = (rem - e * 352) * 8;
        const int row = blk * 64 + (e ? 63 : 0), t = row & 4095;
        const bf16_t* sb = SIDE + (size_t)blk * 6 * 2816 + ch;
        float am[8], a0[8], ap[8], bv[8], o[8];
        if (e == 0) { unpack8(*(const u32x4*)(sb), a0); unpack8(*(const u32x4*)(sb + 2816), ap); unpack8(*(const u32x4*)(sb + 4 * 2816), bv);
            if (t > 0) unpack8(*(const u32x4*)(sb - 6 * 2816 + 3 * 2816), am); else {
#pragma unroll
                for (int i = 0; i < 8; ++i) am[i] = 0.f; } }
        else { unpack8(*(const u32x4*)(sb + 2 * 2816), am); unpack8(*(const u32x4*)(sb + 3 * 2816), a0); unpack8(*(const u32x4*)(sb + 5 * 2816), bv);
            if (t < L - 1) unpack8(*(const u32x4*)(sb + 6 * 2816), ap); else {
#pragma unroll
                for (int i = 0; i < 8; ++i) ap[i] = 0.f; } }
#pragma unroll
        for (int i = 0; i < 8; i += 2) { f32x2 v; v.x = cw[ch + i] * am[i] + cw[DFF + ch + i] * a0[i] + cw[2 * DFF + ch + i] * ap[i] + cb[ch + i];
            v.y = cw[ch + i + 1] * am[i + 1] + cw[DFF + ch + i + 1] * a0[i + 1] + cw[2 * DFF + ch + i + 1] * ap[i + 1] + cb[ch + i + 1];
            const f32x2 gl = pg8::gelu_pk(v); o[i] = gl.x * bv[i]; o[i + 1] = gl.y * bv[i + 1]; }
        *(u32x4*)(ACT + (size_t)row * 2816 + ch) = pack8(o); }
}

#define LAS __attribute__((address_space(3)))
#define XB_TMO      128
#define XB_XCNT(j)  (256  + 64 * (j))
#define XB_XSUB(j)  (1280 + 64 * (j))
#define XB_XGEN(j)  (2304 + 64 * (j))
#define XB_TOP      3328
#define XB_TOPGEN   3392
#define XCD_BAR_WORDS 3456
#define XB_SPIN_CAP (1u << 18)

__device__ __forceinline__ unsigned xb_ld(unsigned* p)              { return __hip_atomic_load(p, __ATOMIC_RELAXED, __HIP_MEMORY_SCOPE_AGENT); }
__device__ __forceinline__ unsigned xb_add(unsigned* p, unsigned v) { return __hip_atomic_fetch_add(p, v, __ATOMIC_RELAXED, __HIP_MEMORY_SCOPE_AGENT); }
__device__ __forceinline__ unsigned xb_xcc_id() { return (unsigned)__builtin_amdgcn_s_getreg((3 << 11) | 20) & 0xFu; }
#define XB_SPIN(cond, bar) do { unsigned _sp = 0; while (cond) { __builtin_amdgcn_s_sleep(1); \
    if ((++_sp & 255u) == 0u) { if (xb_ld(&(bar)[XB_TMO])) break; if (_sp > XB_SPIN_CAP) { atomicAdd(&(bar)[XB_TMO], 1u); break; } } } } while (0)

struct XcdBarrier {
    unsigned* bar; unsigned x;
    volatile LAS unsigned* st;
};

__device__ __forceinline__ XcdBarrier xcd_barrier_post(unsigned* bar, volatile LAS unsigned* st) {
    XcdBarrier b; b.bar = bar; b.x = xb_xcc_id(); b.st = st;
    if (threadIdx.x == 0) (void)xb_add(&bar[XB_XCNT(b.x)], 1u);
    return b;
}
__device__ __forceinline__ void xcd_barrier_complete(unsigned* bar, unsigned x, unsigned& nloc, unsigned& nx) {
    const unsigned G = gridDim.x * gridDim.y * gridDim.z;
    unsigned sum, cnt, mine, sp = 0u;
    for (;;) {
        sum = 0u; cnt = 0u; mine = 0u;
#pragma unroll
        for (unsigned j = 0; j < 16; ++j) { const unsigned c = xb_ld(&bar[XB_XCNT(j)]); sum += c; cnt += (c > 0u) ? 1u : 0u; mine = (j == x) ? c : mine; }
        if (sum == G) break;
        __builtin_amdgcn_s_sleep(1);
        if ((++sp & 255u) == 0u) { if (xb_ld(&bar[XB_TMO])) break; if (sp > XB_SPIN_CAP) { atomicAdd(&bar[XB_TMO], 1u); break; } }
    }
    nloc = mine > 0u ? mine : 1u; nx = cnt > 0u ? cnt : 1u;
}

__device__ __forceinline__ void xcd_barrier(const XcdBarrier& b) {
    asm volatile("s_waitcnt vmcnt(0)" ::: "memory");
    __syncthreads();
    if (threadIdx.x == 0) {
        unsigned* bar = b.bar;
        __builtin_amdgcn_s_waitcnt(0);
        unsigned nloc = b.st[0], nx = b.st[1];
        if (nloc == 0u) { xcd_barrier_complete(bar, b.x, nloc, nx); b.st[0] = nloc; b.st[1] = nx; }
        const unsigned old = xb_add(&bar[XB_XSUB(b.x)], 1u);
        const unsigned gen = old / nloc;
        if (old + 1u == (gen + 1u) * nloc) {
            __builtin_amdgcn_fence(__ATOMIC_RELEASE, "agent");
            asm volatile("s_waitcnt vmcnt(0)" ::: "memory");
            const unsigned og = xb_add(&bar[XB_TOP], 1u);
            const unsigned tg = og / nx;
            if (og + 1u == (tg + 1u) * nx) xb_add(&bar[XB_TOPGEN], 1u);
            else XB_SPIN(xb_ld(&bar[XB_TOPGEN]) == tg, bar);
            __builtin_amdgcn_fence(__ATOMIC_ACQUIRE, "agent");
            xb_add(&bar[XB_XGEN(b.x)], 1u);
            asm volatile("s_waitcnt vmcnt(0)" ::: "memory");
        } else {
            XB_SPIN(xb_ld(&bar[XB_XGEN(b.x)]) == gen, bar);
            __builtin_amdgcn_fence(__ATOMIC_ACQUIRE, "agent");
            asm volatile("s_waitcnt vmcnt(0)" ::: "memory");
        }
    }
    __syncthreads();
}

__device__ __forceinline__ const void* launder_ptr(const void* p) {
    unsigned long long v = (unsigned long long)p; asm volatile("" : "+s"(v)); return (const void*)v; }
typedef const float* fptr_t;
typedef __attribute__((address_space(4))) const fptr_t* kin_t;
#define IN(i) (kin[i])
__global__ void __launch_bounds__(512, 2) mega_fwd(Args args) {
    extern __shared__ __attribute__((aligned(16))) unsigned char lds[];
    cg::grid_group grid = cg::this_grid();
    Ctx c; c.out = args.out; c.ws = args.ws; c.lds = lds;
    PG8_LAS unsigned char* glds = (PG8_LAS unsigned char*)lds;
    int nbar = 0;
    if (threadIdx.x < 2) ((volatile LAS unsigned*)(glds + 131072))[threadIdx.x] = 0u;
    __syncthreads();
    XcdBarrier xb; xb.bar = (unsigned*)(args.ws + WS_BAR); xb.x = 0; xb.st = (volatile LAS unsigned*)(glds + 131072);
#pragma unroll 1
    for (int ph = args.ph_lo; ph < args.ph_hi; ++ph) {
        if (ph > args.ph_lo) { if (nbar == 0) { grid.sync(); xb = xcd_barrier_post((unsigned*)(args.ws + WS_BAR), (volatile LAS unsigned*)(glds + 131072)); } else xcd_barrier(xb); ++nbar; }
        { int t_ = threadIdx.x; asm volatile("" : "+v"(t_)); c.tid = t_; c.lane = t_ & 63; c.wave = __builtin_amdgcn_readfirstlane(t_ >> 6); }
        { int g_ = gridDim.x, b_ = blockIdx.x; asm volatile("" : "+s"(g_), "+s"(b_)); c.G = g_; c.bid = b_; }
        kin_t kin = (kin_t)__builtin_amdgcn_kernarg_segment_ptr(); asm volatile("" : "+s"(kin));
        c.ws = (unsigned char*)launder_ptr(args.ws); c.out = (float*)launder_ptr(args.out);
        bf16_t* const Hb = (bf16_t*)(c.ws + WS_H);
        bf16_t* const XB = (bf16_t*)c.out + (size_t)M * D;
#ifdef DBG_STOP
        if (ph == 100) { const bf16_t* src = (const bf16_t*)(c.ws + DBG_OFF); for (int i = c.bid * 512 + c.tid; i < M * 1024; i += c.G * 512) c.out[i] = bf2f(src[i]); continue; }
#endif
        if (ph == 0) { if (!((PHMASK >> 10) & 1)) continue;
            if (c.bid == 0) for (int i = c.tid; i < XCD_BAR_WORDS; i += 512) __hip_atomic_store((unsigned*)(c.ws + WS_BAR) + i, 0u, __ATOMIC_RELAXED, __HIP_MEMORY_SCOPE_AGENT);
            convert_mix_weights(c, 0, IN(5), IN(19), IN(20), IN(21), IN(22), IN(23), IN(24));
            hyena_hidden(c, IN(8), IN(9), IN(10), IN(11), IN(12), IN(13));
            rowwise(c, IN(0), nullptr, nullptr, nullptr, XB, nullptr, nullptr, IN(1), Hb);
            continue;
        }
        const int l = (ph - 1) / 10, k = (ph - 1) % 10;
        if (!((PHMASK >> k) & 1)) continue;
        if (k == 0) {
            { pg8::Gemm g{(const bf16_t*)(c.ws + WS_WIN), Hb, 1536, M, 1024, 1024, 1024}; pg8::StaticOrder S; S.init(1536, M, c.G, c.bid);
              EpiUT E{(bf16_t*)(c.ws + WS_UT)}; pg8::gemm_phase<EpiUT, pg8::StaticOrder, true, true>(glds, g, S, E); }
            { pg8::Gemm g{Hb, (const bf16_t*)(c.ws + WS_WIN) + (size_t)1536 * 1024, M, 2816, 1024, 1024, 1024}; pg8::StaticOrder S; S.init(M, 2816, c.G, c.bid);
              EpiProj E{(bf16_t*)(c.ws + WS_QKVG), (bf16_t*)(c.ws + WS_POOL), (bf16_t*)(c.ws + WS_LR)}; pg8::gemm_phase<EpiProj, pg8::StaticOrder, true, true>(glds, g, S, E); }
            if (c.G == 256) hyena_taps(c, l, IN(14), 128, 128); else hyena_taps(c, l, IN(14), 0, c.G);
        } else if (k == 1) {
            const bool split = (c.G >= 256);
            if (!split || c.bid < 128) for (int it = c.bid; it < 128; it += (split ? 128 : c.G)) gla_item(c, l, it, IN(16), IN(17));
            {
                { float2* TW = (float2*)c.lds; const float2* TW8 = (const float2*)(c.ws + WS_TW8);
                  __syncthreads();
                  for (int i = c.tid; i < 2048; i += 512) TW[i] = TW8[2 * i];
                  __syncthreads(); }
                const int ch0 = split ? (c.bid < 128 ? 512 : c.bid - 128) : c.bid, ch1 = 512, chs = split ? 128 : c.G;
#pragma unroll 1
                for (int ch = ch0; ch < ch1; ch += chs) fft_item(c, l, ch, IN(14), IN(6), IN(7), IN(15));
            }
            pool_stencil(c, split ? 128 : c.G);
            if (split) convert_wup(c, l, IN(25), 128);
        } else if (k == 2) {
            post_phase(c, l, IN(18));
        } else if (k == 3) {
            { pg8::Gemm g{Hb, (const bf16_t*)(c.ws + WS_WG), M, 3072, 1024, 1024, 1024}; GateOrder S; S.init(M, 1024, c.G, c.bid);
              EpiGate E{(bf16_t*)(c.ws + WS_TMP)}; pg8::gemm_phase<EpiGate, GateOrder, true, true>(glds, g, S, E); }
#pragma unroll 1
            for (int br = 0; br < 3; ++br) {
                const bf16_t* Y = (const bf16_t*)(c.ws + (br == 0 ? WS_YHY : (br == 1 ? WS_YGLA : WS_YPOOL)));
                pg8::Gemm g{Y, (const bf16_t*)(c.ws + WS_WBR) + (size_t)br * 1024 * 512, M, 1024, 512, 512, 512}; pg8::StaticOrder S; S.init(M, 1024, c.G, c.bid);
                EpiBranch E{(const bf16_t*)(c.ws + WS_TMP) + br * 1024, (bf16_t*)(c.ws + WS_MERGED), br == 0}; pg8::gemm_phase<EpiBranch, pg8::StaticOrder, true, true>(glds, g, S, E);
            }
        } else if (k == 4) {
            pg8::Gemm g{(const bf16_t*)(c.ws + WS_MERGED), (const bf16_t*)(c.ws + WS_WOUT), M, 1024, 1024, 1024, 1024}; pg8::StaticOrder S; S.init(M, 1024, c.G, c.bid);
            EpiPlain E{Hb, 1024}; pg8::gemm_phase<EpiPlain, pg8::StaticOrder, true, true>(glds, g, S, E);
        } else if (k == 5) {
            rowwise(c, nullptr, XB, Hb, IN(2) + (size_t)l * D, (l == DEPTH - 1) ? (bf16_t*)(c.ws + WS_XBW) : XB, nullptr, nullptr, IN(3) + (size_t)l * D, Hb);
            if (c.G < 256) convert_wup(c, l, IN(25), 0);
            convert_wdn(c, l, IN(28));
        } else if (k == 6) {
            pg8::Gemm g{Hb, (const bf16_t*)(c.ws + WS_WUP), M, 5632, 1024, 1024, 1024}; pg8::StaticOrder S; S.init(M, 5632, c.G, c.bid);
            EpiAct E{(bf16_t*)(c.ws + WS_ACT), (bf16_t*)(c.ws + WS_SIDE), IN(26) + (size_t)l * 3 * DFF, IN(27) + (size_t)l * DFF}; pg8::gemm_phase<EpiAct, pg8::StaticOrder, true, true>(glds, g, S, E);
        } else if (k == 7) {
            for (int pm = c.bid; pm < M / 256; pm += c.G) act_fixup(c, l, pm, IN(26), IN(27));
        } else if (k == 8) {
            pg8::Gemm g{(const bf16_t*)(c.ws + WS_ACT), (const bf16_t*)(c.ws + WS_WDN), M, 1024, 2816, 2816, 2816}; pg8::StaticOrder S; S.init(M, 1024, c.G, c.bid);
            EpiPlain E{Hb, 1024}; pg8::gemm_phase<EpiPlain, pg8::StaticOrder, true, true>(glds, g, S, E);
        } else {
            const bool lastl = (l == DEPTH - 1);
            if (!lastl) rowwise(c, nullptr, XB, Hb, IN(4) + (size_t)l * D, XB, nullptr, nullptr, IN(1) + (size_t)(l + 1) * D, Hb);
            else rowwise(c, nullptr, (const bf16_t*)(c.ws + WS_XBW), Hb, IN(4) + (size_t)l * D, nullptr, c.out, c.out + (size_t)(M / 2) * D, nullptr, Hb);
            if (!lastl) convert_mix_weights(c, l + 1, IN(5), IN(19), IN(20), IN(21), IN(22), IN(23), IN(24));
        }
    }
}

extern "C" void kernel_launch(void* const* d_in, const int* in_sizes, int n_in, void* d_out, int out_size, void* d_ws, size_t ws_size, hipStream_t stream) {
    static int grid = 0;
    if (grid == 0) {
        if (n_in != 29 || in_sizes[0] != M * D || out_size != M * D || ws_size < WS_END) { fprintf(stderr, "kernel_launch: unexpected shapes / workspace (%d inputs, ws %zu, need %zu)\n", n_in, ws_size, (size_t)WS_END); grid = -1; return; }
        int dev = 0, cus = 0, per_cu = 0;
        if (hipGetDevice(&dev) != hipSuccess || hipDeviceGetAttribute(&cus, hipDeviceAttributeMultiprocessorCount, dev) != hipSuccess) { grid = -1; return; }
        if (hipFuncSetAttribute((const void*)mega_fwd, hipFuncAttributeMaxDynamicSharedMemorySize, LDS_BYTES) != hipSuccess) { fprintf(stderr, "kernel_launch: hipFuncSetAttribute failed\n"); grid = -1; return; }
        if (hipOccupancyMaxActiveBlocksPerMultiprocessor(&per_cu, (const void*)mega_fwd, 512, LDS_BYTES) != hipSuccess || per_cu < 1) { fprintf(stderr, "kernel_launch: occupancy query says %d\n", per_cu); per_cu = 1; }
        (void)hipGetLastError();
        grid = cus;
    }
    if (grid < 0) return;
    Args a{};
    for (int i = 0; i < 29; ++i) a.in[i] = (const float*)d_in[i];
    a.out = (float*)d_out; a.ws = (unsigned char*)d_ws;
#if MK_PER_PHASE_LAUNCH
#ifdef DBG_STOP
    for (int ph = 0; ph < DBG_STOP; ++ph) { a.ph_lo = ph; a.ph_hi = ph + 1; hipLaunchKernelGGL(mega_fwd, dim3(grid), dim3(512), LDS_BYTES, stream, a); }
    a.ph_lo = 100; a.ph_hi = 101; hipLaunchKernelGGL(mega_fwd, dim3(grid), dim3(512), LDS_BYTES, stream, a);
#else
    for (int ph = 0; ph < N_PHASES; ++ph) { a.ph_lo = ph; a.ph_hi = ph + 1; hipLaunchKernelGGL(mega_fwd, dim3(grid), dim3(512), LDS_BYTES, stream, a); }
#endif
#else
    a.ph_lo = 0; a.ph_hi = N_PHASES;
    void* kargs[] = {&a};
    const hipError_t e = hipLaunchCooperativeKernel((const void*)mega_fwd, dim3(grid), dim3(512), kargs, LDS_BYTES, stream);
    if (e != hipSuccess) fprintf(stderr, "kernel_launch: cooperative launch failed: %s (grid %d)\n", hipGetErrorString(e), grid);
#endif
}
```

```cpp
#include <hip/hip_runtime.h>
#include <hip/hip_cooperative_groups.h>
#include <cstdio>
#include <cstdint>
namespace cg = cooperative_groups;
#ifndef MK_PER_PHASE_LAUNCH
#define MK_PER_PHASE_LAUNCH 0
#endif
#include <hip/hip_runtime.h>
#include <cstdio>
#include <cstdint>
namespace pg8 {
#define PG8_LAS __attribute__((address_space(3)))
typedef unsigned short bf16_t;
typedef short bf16x8 __attribute__((ext_vector_type(8)));
typedef float f32x4 __attribute__((ext_vector_type(4)));
typedef unsigned u32x4 __attribute__((ext_vector_type(4)));
constexpr int BM = 256, BK = 64, HALF = 128, HTB = HALF * BK * 2  , STAGE_BYTES = 8 * HTB, NXCD = 8, WGM = 8;

__host__ __device__ __forceinline__ int lds_byte(int r, int c) { const int st = (r >> 4) * 2 + (c >> 5), rr = r & 15, cc = c & 31, ob = rr * 64 + cc * 2; return st * 1024 + (ob ^ (((ob >> 9) & 1) << 5)); }
__host__ __device__ __forceinline__ void stage_rc(int b, int& R, int& C) { const int st = b / 1024, sb = b % 1024, swz = sb ^ (((sb >> 9) & 1) << 5); R = (st >> 1) * 16 + swz / 64; C = (st & 1) * 32 + (swz % 64) / 2; }
__host__ __device__ __forceinline__ int perm32(int rho) { const int n = rho >> 4, i = rho & 15; return 8 * (i >> 2) + 4 * n + (i & 3); }

struct Unit { int pm, pn; };
struct Gemm { const bf16_t* A; const bf16_t* Bt; int M, N, K, lda, ldb; };

struct StaticOrder {
    int nM, nN, nwg, G, c;
    __host__ __device__ void init(int M, int N, int G_, int c_) { nM = M / BM; nN = N / BM; nwg = nM * nN; G = G_; c = c_; }
    __host__ __device__ bool next(int i, Unit& u) const {
        const long L = (long)i * G + c; if (L >= nwg) return false;
        int wgid = (int)L; { const int q = nwg / NXCD, r = nwg % NXCD, xcd = wgid % NXCD, off = wgid / NXCD; wgid = (xcd < r ? xcd * (q + 1) : r * (q + 1) + (xcd - r) * q) + off; }
        const int nig = WGM * nN, gid = wgid / nig, fm = gid * WGM, gsz = (nM - fm) < WGM ? (nM - fm) : WGM;
        u.pm = fm + ((wgid % nig) % gsz); u.pn = (wgid % nig) / gsz; return true;
    }
    __device__ __forceinline__ void a_ready(const Unit&) const {}
    __device__ __forceinline__ void done(const Unit&) const {}
};
typedef float f32x2 __attribute__((ext_vector_type(2)));
typedef __bf16 bf16x2_t __attribute__((ext_vector_type(2)));
__device__ __forceinline__ unsigned cvt_pk_bf16(float lo, float hi) { const f32x2 v = {lo, hi}; const bf16x2_t h = __builtin_convertvector(v, bf16x2_t); return __builtin_bit_cast(unsigned, h); }
__device__ __forceinline__ f32x2 gelu_pk(f32x2 v) {
    const f32x2 av = __builtin_elementwise_abs(v), d = av * 0.2316418882f + 1.0f;
    f32x2 t; t.x = __builtin_amdgcn_rcpf(d.x); t.y = __builtin_amdgcn_rcpf(d.y);
    f32x2 q = t * 0.5307027145f + (-0.7265760135f); q = q * t + 0.7107068705f; q = q * t + (-0.142248368f); q = q * t + 0.127414796f; q = q * t;
    const f32x2 s = (v * v) * (-0.72134752044f);
    f32x2 e; e.x = __builtin_amdgcn_exp2f(s.x); e.y = __builtin_amdgcn_exp2f(s.y);
    const f32x2 m = v * (q * e), r = v - m;
    f32x2 o; o.x = v.x < 0.f ? m.x : r.x; o.y = v.y < 0.f ? m.y : r.y; return o;
}
template <class Epi, class Sched, bool ALIGN_EPI = false, bool SP2 = false>
__device__ __forceinline__ void gemm_phase(PG8_LAS unsigned char* lds, const Gemm g, const Sched& S, const Epi& E) {
    int tid_ = threadIdx.x; asm volatile("" : "+v"(tid_)); const int tid = tid_, wid = __builtin_amdgcn_readfirstlane(tid >> 6), lane = tid & 63, wr = wid >> 2, wc = wid & 3, fr = lane & 15, fq = lane >> 4;
    const int K = g.K, nt = K / BK;
    unsigned voffA[2], voffB[2];
#pragma unroll
    for (int i = 0; i < 2; ++i) { int R, C; stage_rc(tid * 16 + i * 8192, R, C); const int Rb = Epi::PERM ? ((R & ~31) + perm32(R & 31)) : R;
        voffA[i] = (unsigned)(R * g.lda + C) * 2u; voffB[i] = (unsigned)(Rb * g.ldb + C) * 2u; }
    const size_t kstep = (size_t)(BK * 2);
    const size_t hstepA = (size_t)HALF * g.lda * 2, hstepB = (size_t)HALF * g.ldb * 2;
    const size_t tstepA = 2 * hstepA, tstepB = 2 * hstepB;
    const unsigned ldsw = (unsigned)wid * 1024u;
    const int aoff = lds_byte(wr * 64 + fr, fq * 8), boff = lds_byte(wc * 32 + fr, fq * 8);
#define PG8_SA(b, h) (((b) * 2 + (h)) * HTB)
#define PG8_SB(b, h) ((4 + (b) * 2 + (h)) * HTB)
#define PG8_STAGE(bufoff, gbase, voff) do { _Pragma("unroll") for (int _i = 0; _i < 2; ++_i) \
        __builtin_amdgcn_global_load_lds((const unsigned*)((const char*)(gbase) + (voff)[_i]), (PG8_LAS unsigned*)(lds + (bufoff) + ldsw + _i * 8192), 16, 0, 0); } while (0)
#define PG8_LDA(dst, b, h) do { _Pragma("unroll") for (int m = 0; m < 4; ++m) _Pragma("unroll") for (int k = 0; k < 2; ++k) dst[m][k] = *(const PG8_LAS bf16x8*)(lds + PG8_SA(b, h) + aoff + m * 2048 + k * 1024); } while (0)
#define PG8_LDB(dst, b, h) do { _Pragma("unroll") for (int n = 0; n < 2; ++n) _Pragma("unroll") for (int k = 0; k < 2; ++k) dst[n][k] = *(const PG8_LAS bf16x8*)(lds + PG8_SB(b, h) + boff + n * 2048 + k * 1024); } while (0)
#define PG8_MMA(ai, bj, At, Bt) do { __builtin_amdgcn_s_setprio(1); _Pragma("unroll") for (int m = 0; m < 4; ++m) _Pragma("unroll") for (int n = 0; n < 2; ++n) _Pragma("unroll") for (int k = 0; k < 2; ++k) \
        acc[ai][bj][m][n] = __builtin_amdgcn_mfma_f32_16x16x32_bf16(Bt[n][k], At[m][k], acc[ai][bj][m][n], 0, 0, 0); __builtin_amdgcn_s_setprio(0); } while (0)
#define PG8_WAIT_V(n) asm volatile("s_waitcnt vmcnt(" #n ")" ::: "memory")
#define PG8_WAIT_L(n) asm volatile("s_waitcnt lgkmcnt(" #n ")" ::: "memory")
#define PG8_BAR __builtin_amdgcn_s_barrier()
#define PG8_SCHED __builtin_amdgcn_sched_barrier(0)
    Unit cur, nxt; int ui = 0;
    if (!S.next(0, cur)) return;
    f32x4 acc[2][2][4][2];
#pragma unroll
    for (int a = 0; a < 2; ++a)
#pragma unroll
        for (int b = 0; b < 2; ++b)
#pragma unroll
            for (int m = 0; m < 4; ++m)
#pragma unroll
                for (int n = 0; n < 2; ++n) acc[a][b][m][n] = (f32x4){0.f, 0.f, 0.f, 0.f};
    bf16x8 At[4][2], B0[2][2], B1[2][2];
    const char* cA = (const char*)g.A + (size_t)cur.pm * tstepA; const char* cB = (const char*)g.Bt + (size_t)cur.pn * tstepB;
    S.a_ready(cur);
    if constexpr (SP2) {
        PG8_STAGE(PG8_SB(0, 0), cB, voffB); PG8_STAGE(PG8_SB(0, 1), cB + hstepB, voffB); PG8_STAGE(PG8_SA(0, 0), cA, voffA); PG8_STAGE(PG8_SA(0, 1), cA + hstepA, voffA);
        if (wr == 1) PG8_BAR;
        PG8_WAIT_V(2); PG8_BAR;
        PG8_STAGE(PG8_SB(1, 0), cB + kstep, voffB); PG8_STAGE(PG8_SA(1, 0), cA + kstep, voffA); PG8_STAGE(PG8_SB(1, 1), cB + hstepB + kstep, voffB);
        PG8_WAIT_V(6); PG8_BAR;
    } else {
        PG8_STAGE(PG8_SB(0, 0), cB, voffB); PG8_STAGE(PG8_SA(0, 0), cA, voffA); PG8_STAGE(PG8_SB(0, 1), cB + hstepB, voffB); PG8_STAGE(PG8_SA(0, 1), cA + hstepA, voffA);
        if (wr == 1) PG8_BAR;
        PG8_WAIT_V(4); PG8_BAR;
        PG8_STAGE(PG8_SB(1, 0), cB + kstep, voffB); PG8_STAGE(PG8_SA(1, 0), cA + kstep, voffA); PG8_STAGE(PG8_SB(1, 1), cB + hstepB + kstep, voffB);
        PG8_WAIT_V(6); PG8_BAR;
    }
    for (;;) {
        const bool has_next = S.next(ui + 1, nxt);
        const char* nA = has_next ? (const char*)g.A + (size_t)nxt.pm * tstepA : cA; const char* nB = has_next ? (const char*)g.Bt + (size_t)nxt.pn * tstepB : cB;
        for (int t = 0; t < nt; t += 2) {
            const bool last = (t == nt - 2);
            const char* a1 = cA + (size_t)(t + 1) * kstep;
            const char* a2 = last ? nA : cA + (size_t)(t + 2) * kstep; const char* b2 = last ? nB : cB + (size_t)(t + 2) * kstep;
            const char* a3 = a2 + kstep; const char* b3 = b2 + kstep;
            if (last && has_next) S.a_ready(nxt);
            if constexpr (SP2) {
            PG8_LDB(B0, 0, 0); PG8_LDB(B1, 0, 1); PG8_SCHED; PG8_LDA(At, 0, 0); PG8_STAGE(PG8_SA(1, 1), a1 + hstepA, voffA);
            PG8_WAIT_V(8); PG8_WAIT_L(0); PG8_BAR; PG8_MMA(0, 0, At, B0); PG8_MMA(0, 1, At, B1); PG8_BAR; PG8_SCHED;
            PG8_LDA(At, 0, 1); PG8_STAGE(PG8_SB(0, 0), b2, voffB); PG8_STAGE(PG8_SB(0, 1), b2 + hstepB, voffB); PG8_STAGE(PG8_SA(0, 0), a2, voffA);
            PG8_WAIT_V(8); PG8_WAIT_L(0); PG8_BAR; PG8_MMA(1, 0, At, B0); PG8_MMA(1, 1, At, B1); PG8_BAR; PG8_SCHED;
            PG8_LDB(B0, 1, 0); PG8_LDB(B1, 1, 1); PG8_SCHED; PG8_LDA(At, 1, 0); PG8_STAGE(PG8_SA(0, 1), a2 + hstepA, voffA);
            PG8_WAIT_V(8); PG8_WAIT_L(0); PG8_BAR; PG8_MMA(0, 0, At, B0); PG8_MMA(0, 1, At, B1); PG8_BAR; PG8_SCHED;
            PG8_LDA(At, 1, 1); PG8_STAGE(PG8_SB(1, 0), b3, voffB); PG8_STAGE(PG8_SB(1, 1), b3 + hstepB, voffB); PG8_STAGE(PG8_SA(1, 0), a3, voffA);
            PG8_WAIT_V(8); PG8_WAIT_L(0); PG8_BAR; PG8_MMA(1, 0, At, B0); PG8_MMA(1, 1, At, B1); PG8_BAR; PG8_SCHED;
            } else {
            PG8_LDB(B0, 0, 0); PG8_SCHED; PG8_LDA(At, 0, 0); PG8_STAGE(PG8_SA(1, 1), a1 + hstepA, voffA);
            PG8_WAIT_L(8); PG8_BAR; PG8_WAIT_L(0); PG8_MMA(0, 0, At, B0); PG8_BAR; PG8_SCHED;
            PG8_LDB(B1, 0, 1); PG8_STAGE(PG8_SB(0, 0), b2, voffB);
            PG8_BAR; PG8_WAIT_L(0); PG8_MMA(0, 1, At, B1); PG8_BAR;
            PG8_LDA(At, 0, 1); PG8_STAGE(PG8_SA(0, 0), a2, voffA);
            PG8_BAR; PG8_WAIT_L(0); PG8_MMA(1, 0, At, B0); PG8_BAR; PG8_SCHED;
            PG8_STAGE(PG8_SB(0, 1), b2 + hstepB, voffB);
            PG8_WAIT_V(6); PG8_BAR; PG8_MMA(1, 1, At, B1); PG8_BAR;
            PG8_LDB(B0, 1, 0); PG8_SCHED; PG8_LDA(At, 1, 0); PG8_STAGE(PG8_SA(0, 1), a2 + hstepA, voffA);
            PG8_WAIT_L(8); PG8_BAR; PG8_WAIT_L(0); PG8_MMA(0, 0, At, B0); PG8_BAR; PG8_SCHED;
            PG8_LDB(B1, 1, 1); PG8_STAGE(PG8_SB(1, 0), b3, voffB);
            PG8_BAR; PG8_WAIT_L(0); PG8_MMA(0, 1, At, B1); PG8_BAR;
            PG8_LDA(At, 1, 1); PG8_STAGE(PG8_SA(1, 0), a3, voffA);
            PG8_BAR; PG8_WAIT_L(0); PG8_MMA(1, 0, At, B0); PG8_BAR; PG8_SCHED;
            PG8_STAGE(PG8_SB(1, 1), b3 + hstepB, voffB);
            PG8_WAIT_V(6); PG8_BAR; PG8_MMA(1, 1, At, B1); PG8_BAR;
            }
        }
        if constexpr (ALIGN_EPI) { if (wr == 0) PG8_BAR; }
        if constexpr (!Epi::AFTER_DRAIN) { E(acc, cur, wr, wc, fr, fq); S.done(cur); }
        if (!has_next) break;
#pragma unroll
        for (int a = 0; a < 2; ++a)
#pragma unroll
            for (int b = 0; b < 2; ++b)
#pragma unroll
                for (int m = 0; m < 4; ++m)
#pragma unroll
                    for (int n = 0; n < 2; ++n) acc[a][b][m][n] = (f32x4){0.f, 0.f, 0.f, 0.f};
        cur = nxt; cA = nA; cB = nB; ++ui;
        if constexpr (ALIGN_EPI) { if (wr == 1) PG8_BAR; }
    }
    PG8_WAIT_V(0);
    if constexpr (!ALIGN_EPI) { if (wr == 0) PG8_BAR; }
    PG8_BAR;
    if constexpr (Epi::AFTER_DRAIN) { E.fused(acc, cur, wr, wc, fr, fq, lds, wid, lane); S.done(cur); }
#undef PG8_SA
#undef PG8_SB
#undef PG8_STAGE
#undef PG8_LDA
#undef PG8_LDB
#undef PG8_MMA
#undef PG8_WAIT_V
#undef PG8_WAIT_L
#undef PG8_BAR
#undef PG8_SCHED
}
}


using pg8::bf16_t; using pg8::bf16x8; using pg8::f32x4; using pg8::u32x4; using pg8::Unit; using pg8::cvt_pk_bf16; using pg8::f32x2;
typedef unsigned u32x2 __attribute__((ext_vector_type(2)));

constexpr int D = 1024, NB = 8, L = 4096, M = NB * L, DEPTH = 4, DIN = 7200, DFF = 2816;
constexpr int C_LR = 3584, C_POOL = 3616, C_GATE = 4128;
constexpr int NWIN = 4352;
constexpr float EPS = 1e-6f;
constexpr size_t SZ512 = (size_t)M * 512 * 2;
constexpr size_t WS_WIN = 0;
constexpr size_t WS_WG = WS_WIN + (size_t)NWIN * 1024 * 2;
constexpr size_t WS_WBR = WS_WG + (size_t)3072 * 1024 * 2;
constexpr size_t WS_WOUT = WS_WBR + (size_t)3 * 1024 * 512 * 2;
constexpr size_t WS_H = WS_WOUT + (size_t)1024 * 1024 * 2;
constexpr size_t WS_HID = WS_H + (size_t)M * 1024 * 2;
constexpr size_t WS_TW8 = WS_HID + (size_t)4 * 4096 * 64 * 4;
constexpr size_t WS_BAR = WS_TW8 + 4096 * 8;
constexpr size_t WS_AR = WS_BAR + 16384;
constexpr size_t WS_UT = WS_AR;
constexpr size_t WS_QKVG = WS_UT + 3 * SZ512;
constexpr size_t WS_POOL = WS_QKVG + 4 * SZ512;
constexpr size_t WS_LR = WS_POOL + SZ512;
constexpr size_t WS_YHY = WS_LR + (size_t)M * 32 * 2;
constexpr size_t WS_YGLA = WS_YHY + SZ512;
constexpr size_t WS_YPOOL = WS_YGLA + SZ512;
constexpr size_t WS_OB = WS_YPOOL + SZ512;
constexpr size_t WS_END_MIX = WS_OB + SZ512;
constexpr size_t WS_TMP = WS_UT;
constexpr size_t WS_MERGED = WS_TMP + (size_t)M * 3072 * 2;
static_assert(WS_MERGED + (size_t)M * 1024 * 2 <= WS_YHY, "merge scratch must end before the live branch outputs");
constexpr size_t WS_AB = WS_AR;
constexpr size_t WS_ACT = WS_AR;
constexpr size_t WS_SIDE = WS_ACT + (size_t)M * 2816 * 2;
constexpr size_t WS_END_FFN = WS_AB + (size_t)M * 5632 * 2;
constexpr size_t WS_XBW = WS_AR + ((size_t)256 << 20);
static_assert(WS_XBW >= WS_SIDE + (size_t)(M / 64) * 6 * 2816 * 2 && WS_XBW + (size_t)M * 1024 * 2 <= WS_END_MIX, "residual copy must sit behind the FFN activations, inside the arena");
constexpr size_t WS_TAPS = WS_END_MIX;
constexpr size_t WS_WUP = WS_TAPS + (size_t)1024 * 4096 * 4;
constexpr size_t WS_WDN = WS_WUP + (size_t)5632 * 1024 * 2;
constexpr size_t WS_END = WS_WDN + (size_t)1024 * 2816 * 2;
static_assert(WS_END_FFN <= WS_TAPS, "FFN-stage buffers must end before the taps");
constexpr int LDS_BYTES = 132 * 1024;
constexpr int N_PHASES = 1 + DEPTH * 10;
#ifndef PHMASK
#define PHMASK 0x7FF
#endif

__device__ __forceinline__ float bf2f(unsigned u16) { return __uint_as_float(u16 << 16); }
__device__ __forceinline__ float bflo(unsigned w) { return __uint_as_float(w << 16); }
__device__ __forceinline__ float bfhi(unsigned w) { return __uint_as_float(w & 0xffff0000u); }
__device__ __forceinline__ bf16_t f2bf(float f) { const __bf16 h = (__bf16)f; return __builtin_bit_cast(bf16_t, h); }
__device__ __forceinline__ void unpack8(const u32x4 w, float* v) {
    v[0] = bflo(w.x); v[1] = bfhi(w.x); v[2] = bflo(w.y); v[3] = bfhi(w.y); v[4] = bflo(w.z); v[5] = bfhi(w.z); v[6] = bflo(w.w); v[7] = bfhi(w.w); }
__device__ __forceinline__ u32x4 pack8(const float* v) { u32x4 w; w.x = cvt_pk_bf16(v[0], v[1]); w.y = cvt_pk_bf16(v[2], v[3]); w.z = cvt_pk_bf16(v[4], v[5]); w.w = cvt_pk_bf16(v[6], v[7]); return w; }
__device__ __forceinline__ float wave_sum(float v) {
#pragma unroll
    for (int o = 32; o; o >>= 1) v += __shfl_xor(v, o);
    return v; }

struct EpiPlain {
    static constexpr bool PERM = true, AFTER_DRAIN = false;
    bf16_t* O; int ldc;
    __device__ __forceinline__ void operator()(const f32x4 (&acc)[2][2][4][2], const Unit& u, int wr, int wc, int fr, int fq) const {
        const int row0 = u.pm * 256 + wr * 64 + fr, col0 = u.pn * 256 + wc * 32 + 8 * fq;
#pragma unroll
        for (int ai = 0; ai < 2; ++ai)
#pragma unroll
            for (int m = 0; m < 4; ++m) { bf16_t* rowp = O + (size_t)(row0 + ai * 128 + m * 16) * ldc + col0;
#pragma unroll
                for (int bj = 0; bj < 2; ++bj) { const f32x4 v0 = acc[ai][bj][m][0], v1 = acc[ai][bj][m][1];
                    u32x4 w; w.x = cvt_pk_bf16(v0[0], v0[1]); w.y = cvt_pk_bf16(v0[2], v0[3]); w.z = cvt_pk_bf16(v1[0], v1[1]); w.w = cvt_pk_bf16(v1[2], v1[3]);
                    *(u32x4*)(rowp + bj * 128) = w; } }
    }
};
struct EpiUT {
    static constexpr bool PERM = true, AFTER_DRAIN = false;
    bf16_t* UT;
    __device__ __forceinline__ void operator()(const f32x4 (&acc)[2][2][4][2], const Unit& u, int wr, int wc, int fr, int fq) const {
        const int ch0 = u.pm * 256 + wr * 64 + fr, tok0 = u.pn * 256 + wc * 32 + 8 * fq;
#pragma unroll
        for (int ai = 0; ai < 2; ++ai)
#pragma unroll
            for (int m = 0; m < 4; ++m) { const int ch = ch0 + ai * 128 + m * 16;
#pragma unroll
                for (int bj = 0; bj < 2; ++bj) { const int tok = tok0 + bj * 128, b = tok >> 12, t = tok & 4095;
                    const f32x4 v0 = acc[ai][bj][m][0], v1 = acc[ai][bj][m][1];
                    u32x4 w; w.x = cvt_pk_bf16(v0[0], v0[1]); w.y = cvt_pk_bf16(v0[2], v0[3]); w.z = cvt_pk_bf16(v1[0], v1[1]); w.w = cvt_pk_bf16(v1[2], v1[3]);
                    *(u32x4*)(UT + ((size_t)b * 1536 + ch) * 4096 + t) = w; } }
    }
};
struct EpiProj {
    static constexpr bool PERM = true, AFTER_DRAIN = false;
    bf16_t* QKVG; bf16_t* POOL; bf16_t* LRB;
    __device__ __forceinline__ void operator()(const f32x4 (&acc)[2][2][4][2], const Unit& u, int wr, int wc, int fr, int fq) const {
        const int row0 = u.pm * 256 + wr * 64 + fr; const int cl = wc * 32 + 8 * fq;
        bf16_t* base; int ldc; bool lr = false;
        if (u.pn < 8) { base = QKVG + u.pn * 256 + cl; ldc = 2048; }
        else if (u.pn < 10) { base = POOL + (u.pn - 8) * 256 + cl; ldc = 512; }
        else { base = LRB + cl; ldc = 32; lr = true; }
#pragma unroll
        for (int ai = 0; ai < 2; ++ai)
#pragma unroll
            for (int m = 0; m < 4; ++m) { bf16_t* rowp = base + (size_t)(row0 + ai * 128 + m * 16) * ldc;
#pragma unroll
                for (int bj = 0; bj < 2; ++bj) { const f32x4 v0 = acc[ai][bj][m][0], v1 = acc[ai][bj][m][1];
                    u32x4 w; w.x = cvt_pk_bf16(v0[0], v0[1]); w.y = cvt_pk_bf16(v0[2], v0[3]); w.z = cvt_pk_bf16(v1[0], v1[1]); w.w = cvt_pk_bf16(v1[2], v1[3]);
                    if (!lr) *(u32x4*)(rowp + bj * 128) = w;
                    else if (bj == 0 && wc == 0) *(u32x4*)(rowp) = w; } }
    }
};
struct EpiGate {
    static constexpr bool PERM = true, AFTER_DRAIN = false;
    bf16_t* T;
    __device__ __forceinline__ void operator()(const f32x4 (&acc)[2][2][4][2], const Unit& u, int wr, int wc, int fr, int fq) const {
        const int row0 = u.pm * 256 + wr * 64 + fr, col0 = u.pn * 256 + wc * 32 + 8 * fq;
#pragma unroll
        for (int ai = 0; ai < 2; ++ai)
#pragma unroll
            for (int m = 0; m < 4; ++m) { bf16_t* rowp = T + (size_t)(row0 + ai * 128 + m * 16) * 3072 + col0;
#pragma unroll
                for (int bj = 0; bj < 2; ++bj) { float v[8];
#pragma unroll
                    for (int i = 0; i < 4; ++i) { v[i] = acc[ai][bj][m][0][i]; v[4 + i] = acc[ai][bj][m][1][i]; }
#pragma unroll
                    for (int i = 0; i < 8; ++i) v[i] = fminf(__builtin_amdgcn_rcpf(1.0f + __expf(-v[i])), 1.0f);
                    *(u32x4*)(rowp + bj * 128) = pack8(v); } }
    }
};
struct GateOrder : pg8::StaticOrder {
    __device__ bool next(int i, Unit& u) const { const int ii = i / 3, br = i - 3 * ii; Unit t; if (!pg8::StaticOrder::next(ii, t)) return false; u.pm = t.pm; u.pn = t.pn + 4 * br; return true; }
};
struct EpiBranch {
    static constexpr bool PERM = true, AFTER_DRAIN = false;
    const bf16_t* T; bf16_t* MG; int first;
    __device__ __forceinline__ void operator()(const f32x4 (&acc)[2][2][4][2], const Unit& u, int wr, int wc, int fr, int fq) const {
        const int row0 = u.pm * 256 + wr * 64 + fr, col0 = u.pn * 256 + wc * 32 + 8 * fq;
#pragma unroll
        for (int ai = 0; ai < 2; ++ai)
#pragma unroll
            for (int m = 0; m < 4; ++m) { const size_t off = (size_t)(row0 + ai * 128 + m * 16) * 1024 + col0;
                u32x4 tg[2], tp[2];
                const size_t offg = (size_t)(row0 + ai * 128 + m * 16) * 3072 + col0;
#pragma unroll
                for (int bj = 0; bj < 2; ++bj) { tg[bj] = *(const u32x4*)(T + offg + bj * 128); tp[bj] = first ? (u32x4){0u, 0u, 0u, 0u} : *(const u32x4*)(MG + off + bj * 128); }
#pragma unroll
                for (int bj = 0; bj < 2; ++bj) { float v[8], g[8], p[8];
#pragma unroll
                    for (int i = 0; i < 4; ++i) { v[i] = acc[ai][bj][m][0][i]; v[4 + i] = acc[ai][bj][m][1][i]; }
                    unpack8(tg[bj], g); unpack8(tp[bj], p);
#pragma unroll
                    for (int i = 0; i < 8; ++i) v[i] = v[i] * g[i] + p[i];
                    *(u32x4*)(MG + off + bj * 128) = pack8(v); } }
    }
};

__device__ __forceinline__ float dpp_ror1(float x) { return __int_as_float(__builtin_amdgcn_update_dpp(0, __float_as_int(x), 0x121, 0xF, 0xF, false)); }
__device__ __forceinline__ float dpp_ror15(float x) { return __int_as_float(__builtin_amdgcn_update_dpp(0, __float_as_int(x), 0x12F, 0xF, 0xF, false)); }
struct EpiAct {
    static constexpr bool PERM = true, AFTER_DRAIN = false;
    bf16_t* ACT; bf16_t* SIDE; const float* cw; const float* cb;
    __device__ __forceinline__ void operator()(const f32x4 (&acc)[2][2][4][2], const Unit& u, int wr, int wc, int fr, int fq) const {
        const int c8 = u.pn * 128 + wc * 32 + 8 * fq;
        float w0[8], w1[8], w2[8], bs[8];
#pragma unroll
        for (int i = 0; i < 2; ++i) { const float4 a = *(const float4*)(cw + c8 + 4 * i), b = *(const float4*)(cw + DFF + c8 + 4 * i), d = *(const float4*)(cw + 2 * DFF + c8 + 4 * i), e = *(const float4*)(cb + c8 + 4 * i);
            w0[4 * i] = a.x; w0[4 * i + 1] = a.y; w0[4 * i + 2] = a.z; w0[4 * i + 3] = a.w; w1[4 * i] = b.x; w1[4 * i + 1] = b.y; w1[4 * i + 2] = b.z; w1[4 * i + 3] = b.w;
            w2[4 * i] = d.x; w2[4 * i + 1] = d.y; w2[4 * i + 2] = d.z; w2[4 * i + 3] = d.w; bs[4 * i] = e.x; bs[4 * i + 1] = e.y; bs[4 * i + 2] = e.z; bs[4 * i + 3] = e.w; }
        const bool f0 = (fr == 0), f15 = (fr == 15);
#pragma unroll
        for (int ai = 0; ai < 2; ++ai) { const int rb = u.pm * 256 + ai * 128 + wr * 64; bf16_t* sd = SIDE + (size_t)(rb >> 6) * 6 * 2816 + c8;
#pragma unroll
            for (int m = 0; m < 4; ++m) { float o[8], av[8], bv[8];
#pragma unroll
                for (int n = 0; n < 2; ++n)
#pragma unroll
                    for (int i = 0; i < 4; ++i) { const int q = 4 * n + i; const float a0 = acc[ai][0][m][n][i];
                        const float pa = dpp_ror1(a0), pb = dpp_ror1(acc[ai][0][m > 0 ? m - 1 : 0][n][i]);
                        const float na = dpp_ror15(a0), nb = dpp_ror15(acc[ai][0][m < 3 ? m + 1 : 3][n][i]);
                        const float am = f0 ? pb : pa, ap = f15 ? nb : na;
                        av[q] = a0; bv[q] = acc[ai][1][m][n][i]; o[q] = w0[q] * am + w1[q] * a0 + w2[q] * ap + bs[q]; }
#pragma unroll
                for (int q = 0; q < 8; q += 2) { const f32x2 gl = pg8::gelu_pk((f32x2){o[q], o[q + 1]}); o[q] = gl.x * bv[q]; o[q + 1] = gl.y * bv[q + 1]; }
                const bool edge = (m == 0 && f0) || (m == 3 && f15);
                if (!edge) *(u32x4*)(ACT + (size_t)(rb + 16 * m + fr) * 2816 + c8) = pack8(o);
                if (m == 0 && fr <= 1) { *(u32x4*)(sd + (size_t)fr * 2816) = pack8(av); if (f0) *(u32x4*)(sd + (size_t)4 * 2816) = pack8(bv); }
                if (m == 3 && fr >= 14) { *(u32x4*)(sd + (size_t)(fr - 12) * 2816) = pack8(av); if (f15) *(u32x4*)(sd + (size_t)5 * 2816) = pack8(bv); } } }
    }
};

struct Args { const float* in[29]; float* out; unsigned char* ws; int ph_lo, ph_hi; };
struct Ctx { float* out; unsigned char* ws; unsigned char* lds; int tid, lane, wave, G, bid; };

__device__ __forceinline__ void cvt_job(const Ctx& c, const float* src, int ld, int c0, int K, int N, bf16_t* dst, int& cnt, int il = 0, int boff = 0, int nblk = 0) {
    const int kt = K / 64, ntl = (N + 63) / 64, ntiles = kt * ntl, NW = (nblk ? nblk : c.G) * 8, gw = c.bid * 8 + c.wave;
    const int start = (gw + NW - (cnt % NW)) % NW; cnt += ntiles;
    if (nblk && c.bid >= nblk) return;
    for (int t = start; t < ntiles; t += NW) {
        const int k0 = (t % kt) * 64, n = (t / kt) * 64 + c.lane;
        if (n < N) { const float* sp = src + (size_t)k0 * ld + c0 + n; bf16_t* dp = dst + (size_t)(il ? ((n >> 7) * 256 + (n & 127) + boff) : n) * K + k0;
#pragma unroll 4
            for (int q = 0; q < 8; ++q) { float v[8];
#pragma unroll
                for (int i = 0; i < 8; ++i) v[i] = sp[(size_t)(8 * q + i) * ld];
                *(u32x4*)(dp + 8 * q) = pack8(v); } }
    }
}
__device__ __forceinline__ void convert_mix_weights(const Ctx& c, int l, const float* w_in_all, const float* pool_w, const float* pool_scale, const float* wb0, const float* wb1, const float* wb2, const float* w_out) {
    int cnt = 0;
    const float* w_in = w_in_all + (size_t)l * D * DIN;
    bf16_t* Win = (bf16_t*)(c.ws + WS_WIN);
    cvt_job(c, w_in, DIN, 0, 1024, 3584, Win, cnt);
    cvt_job(c, w_in, DIN, C_LR, 1024, 32, Win + (size_t)4096 * 1024, cnt);
    cvt_job(c, w_in, DIN, C_GATE, 1024, 3072, (bf16_t*)(c.ws + WS_WG), cnt);
    cvt_job(c, wb0 + (size_t)l * 512 * 1024, 1024, 0, 512, 1024, (bf16_t*)(c.ws + WS_WBR), cnt);
    cvt_job(c, wb1 + (size_t)l * 512 * 1024, 1024, 0, 512, 1024, (bf16_t*)(c.ws + WS_WBR) + (size_t)1024 * 512, cnt);
    cvt_job(c, wb2 + (size_t)l * 512 * 1024, 1024, 0, 512, 1024, (bf16_t*)(c.ws + WS_WBR) + (size_t)2 * 1024 * 512, cnt);
    cvt_job(c, w_out + (size_t)l * 1024 * 1024, 1024, 0, 1024, 1024, (bf16_t*)(c.ws + WS_WOUT), cnt);
    const int gt = c.bid * 512 + c.tid, NT = c.G * 512;
    for (int i = gt; i < 224 * 1024 / 2; i += NT) ((unsigned*)(Win + (size_t)4128 * 1024))[i] = 0u;
    const float* pw = pool_w + (size_t)l * 4 * 128 * 128; const float* ps = pool_scale + (size_t)l * 512;
    for (int i = gt; i < 128 * 512; i += NT) { const int kb = (i >> 9) * 8, n = i & 511, g = n >> 7, nn = n & 127;
        const float* wr = w_in + (size_t)kb * DIN + C_POOL + g * 128; const float* pc = pw + (size_t)g * 128 * 128 + nn; float acc[8];
#pragma unroll
        for (int j = 0; j < 8; ++j) acc[j] = 0.f;
#pragma unroll 4
        for (int cc = 0; cc < 128; ++cc) { const float pv = pc[cc * 128];
#pragma unroll
            for (int j = 0; j < 8; ++j) acc[j] += wr[(size_t)j * DIN + cc] * pv; }
        float o[8]; const float sc = ps[n];
#pragma unroll
        for (int j = 0; j < 8; ++j) o[j] = acc[j] * sc;
        *(u32x4*)(Win + (size_t)(3584 + n) * 1024 + kb) = pack8(o); }
}
__device__ __forceinline__ void convert_wup(const Ctx& c, int l, const float* w_up, int nblk) {
    int cnt = 0;
    cvt_job(c, w_up + (size_t)l * 1024 * 5632, 5632, 0, 1024, 2816, (bf16_t*)(c.ws + WS_WUP), cnt, 1, 0, nblk);
    cvt_job(c, w_up + (size_t)l * 1024 * 5632, 5632, 2816, 1024, 2816, (bf16_t*)(c.ws + WS_WUP), cnt, 1, 128, nblk);
}
__device__ __forceinline__ void convert_wdn(const Ctx& c, int l, const float* w_dn) {
    int cnt = 0;
    cvt_job(c, w_dn + (size_t)l * 2816 * 1024, 1024, 0, 2816, 1024, (bf16_t*)(c.ws + WS_WDN), cnt);
}

__device__ __forceinline__ void rowwise(const Ctx& c, const float* xs32, const bf16_t* xs16, const bf16_t* y, const float* gpost, bf16_t* xd16, float* xd32_lo, float* xd32_hi, const float* gpre, bf16_t* hout) {
    const int gw = c.bid * 8 + c.wave, NGW = c.G * 8;
    float gq[16], gp[16];
#pragma unroll
    for (int i = 0; i < 2; ++i) {
#pragma unroll
        for (int j = 0; j < 8; ++j) { gq[8 * i + j] = y ? gpost[512 * i + 8 * c.lane + j] : 0.f; gp[8 * i + j] = gpre ? gpre[512 * i + 8 * c.lane + j] : 0.f; } }
    for (int row0 = gw; row0 < M; row0 += 2 * NGW) {
        float xv[2][16], yv[2][16]; const bool has1 = (row0 + NGW < M);
#pragma unroll
        for (int u = 0; u < 2; ++u) { const int row = (u == 0 || has1) ? row0 + u * NGW : row0;
#pragma unroll
            for (int i = 0; i < 2; ++i) {
                if (xs32) { const float4* p = (const float4*)(xs32 + (size_t)row * D + 512 * i + 8 * c.lane); const float4 a = p[0], b = p[1];
                    xv[u][8 * i] = a.x; xv[u][8 * i + 1] = a.y; xv[u][8 * i + 2] = a.z; xv[u][8 * i + 3] = a.w; xv[u][8 * i + 4] = b.x; xv[u][8 * i + 5] = b.y; xv[u][8 * i + 6] = b.z; xv[u][8 * i + 7] = b.w; }
                else unpack8(*(const u32x4*)(xs16 + (size_t)row * D + 512 * i + 8 * c.lane), xv[u] + 8 * i);
                if (y) unpack8(*(const u32x4*)(y + (size_t)row * D + 512 * i + 8 * c.lane), yv[u] + 8 * i); } }
#pragma unroll
        for (int u = 0; u < 2; ++u) { if (u == 1 && !has1) break; const int row = row0 + u * NGW;
            if (y) { float ss = 0.f;
#pragma unroll
                for (int i = 0; i < 16; ++i) ss += yv[u][i] * yv[u][i];
                ss = wave_sum(ss); const float r = rsqrtf(ss * (1.0f / D) + EPS);
#pragma unroll
                for (int i = 0; i < 16; ++i) xv[u][i] += yv[u][i] * r * gq[i]; }
            if (xd16) {
#pragma unroll
                for (int i = 0; i < 2; ++i) *(u32x4*)(xd16 + (size_t)row * D + 512 * i + 8 * c.lane) = pack8(xv[u] + 8 * i); }
            else { float* dst = (row < M / 2) ? xd32_lo + (size_t)row * D : xd32_hi + (size_t)(row - M / 2) * D;
#pragma unroll
                for (int i = 0; i < 2; ++i) { float4* p = (float4*)(dst + 512 * i + 8 * c.lane);
                    p[0] = make_float4(xv[u][8 * i], xv[u][8 * i + 1], xv[u][8 * i + 2], xv[u][8 * i + 3]); p[1] = make_float4(xv[u][8 * i + 4], xv[u][8 * i + 5], xv[u][8 * i + 6], xv[u][8 * i + 7]); } }
            if (gpre) { float ss = 0.f;
#pragma unroll
                for (int i = 0; i < 16; ++i) ss += xv[u][i] * xv[u][i];
                ss = wave_sum(ss); const float r = rsqrtf(ss * (1.0f / D) + EPS);
#pragma unroll
                for (int i = 0; i < 2; ++i) { float hv[8];
#pragma unroll
                    for (int j = 0; j < 8; ++j) hv[j] = xv[u][8 * i + j] * r * gp[8 * i + j];
                    *(u32x4*)(hout + (size_t)row * D + 512 * i + 8 * c.lane) = pack8(hv); } } }
    }
}

__device__ __forceinline__ void hyena_hidden(const Ctx& c, const float* W1, const float* B1, const float* F1, const float* W2, const float* B2, const float* F2) {
    float* HID = (float*)(c.ws + WS_HID);
    const int gw = c.bid * 8 + c.wave, NGW = c.G * 8, j = c.lane;
    for (int it = gw; it < DEPTH * L; it += NGW) { const int l = it >> 12, t = it & 4095;
        const float* w1 = W1 + (size_t)l * 33 * 64; const float* b1 = B1 + l * 64; const float* f1 = F1 + l * 64;
        const float* w2 = W2 + (size_t)l * 64 * 64; const float* b2 = B2 + l * 64; const float* f2 = F2 + l * 64;
        float z = 0.f;
        { const float wt = 6.283185307179586f * (float)t / (float)L;
          if (j == 0) z = (float)t / (float)(L - 1);
          else if (j <= 32) { const int bi = (j - 1) & 15; const float f = 1e-4f + (float)bi * ((15.0f - 1e-4f) / 15.0f); const float ang = f * wt; z = (j <= 16) ? cosf(ang) : -sinf(ang); } }
        float s = b1[j];
        for (int e = 0; e < 33; ++e) s += __shfl(z, e) * w1[e * 64 + j];
        const float h1 = sinf(f1[j] * s);
        float s2 = b2[j];
        for (int i = 0; i < 64; ++i) s2 += __shfl(h1, i) * w2[i * 64 + j];
        HID[(size_t)it * 64 + j] = sinf(f2[j] * s2);
    }
    float2* TW8 = (float2*)(c.ws + WS_TW8);
    for (int k = c.bid * 512 + c.tid; k < 4096; k += c.G * 512) { float sn, cs; sincospif((float)k * (1.0f / 4096.0f), &sn, &cs); TW8[k] = make_float2(cs, -sn); }
}

__device__ __forceinline__ void hyena_taps(const Ctx& c, int l, const float* W3, int blk0, int nblk) {
    const float* HID = (const float*)(c.ws + WS_HID) + (size_t)l * L * 64; const float* w3 = W3 + (size_t)l * 64 * 1024; float* TAPS = (float*)(c.ws + WS_TAPS);
    float* hs = (float*)c.lds + c.wave * 1024;
    const int gw = (c.bid - blk0) * 8 + c.wave, NGW = nblk * 8;
    if (c.bid >= blk0 && c.bid < blk0 + nblk) for (int it = gw; it < 256 * 4; it += NGW) { const int t0 = (it >> 2) * 16, c0 = (it & 3) * 256 + 4 * c.lane;
#pragma unroll
        for (int q = 0; q < 4; ++q) *(float4*)(hs + q * 256 + 4 * c.lane) = *(const float4*)(HID + (size_t)t0 * 64 + q * 256 + 4 * c.lane);
        float acc[16][4];
#pragma unroll
        for (int r = 0; r < 16; ++r) { acc[r][0] = 0.f; acc[r][1] = 0.f; acc[r][2] = 0.f; acc[r][3] = 0.f; }
#pragma unroll 2
        for (int j0 = 0; j0 < 64; j0 += 4) { float4 wv[4];
#pragma unroll
            for (int q = 0; q < 4; ++q) wv[q] = *(const float4*)(w3 + (size_t)(j0 + q) * 1024 + c0);
#pragma unroll
            for (int r = 0; r < 16; ++r) { const float4 hv = *(const float4*)(hs + r * 64 + j0);
                acc[r][0] += hv.x * wv[0].x + hv.y * wv[1].x + hv.z * wv[2].x + hv.w * wv[3].x; acc[r][1] += hv.x * wv[0].y + hv.y * wv[1].y + hv.z * wv[2].y + hv.w * wv[3].y;
                acc[r][2] += hv.x * wv[0].z + hv.y * wv[1].z + hv.z * wv[2].z + hv.w * wv[3].z; acc[r][3] += hv.x * wv[0].w + hv.y * wv[1].w + hv.z * wv[2].w + hv.w * wv[3].w; } }
#pragma unroll
        for (int cc = 0; cc < 4; ++cc) { float4* o = (float4*)(TAPS + (size_t)(c0 + cc) * 4096 + t0);
#pragma unroll
            for (int q = 0; q < 4; ++q) o[q] = make_float4(acc[4 * q][cc], acc[4 * q + 1][cc], acc[4 * q + 2][cc], acc[4 * q + 3][cc]); }
    }
    __syncthreads();
}

__device__ __forceinline__ float2 cmul(float2 a, float2 b) { float x = a.x * b.x - a.y * b.y; const float y = a.x * b.y + a.y * b.x; asm("" : "+v"(x)); return make_float2(x, y); }
__device__ __forceinline__ float2 cmulc(float2 a, float2 b) { float x = a.x * b.x + a.y * b.y; const float y = a.y * b.x - a.x * b.y; asm("" : "+v"(x)); return make_float2(x, y); }
__device__ __forceinline__ float2 cadd(float2 a, float2 b) { float x = a.x + b.x; const float y = a.y + b.y; asm("" : "+v"(x)); return make_float2(x, y); }
__device__ __forceinline__ float2 csub(float2 a, float2 b) { float x = a.x - b.x; const float y = a.y - b.y; asm("" : "+v"(x)); return make_float2(x, y); }
#define XP(i) ((i) + ((i) >> 5))
__device__ __forceinline__ void fft_fwd(float2* X, const float2* TW, int tid, const float2* Kmul = nullptr) {
    const float RS = 0.70710678118654752f;
#pragma unroll 1
    for (int lh = 9; lh >= 0; lh -= 3) { const int h = 1 << lh, j = tid & (h - 1), i = ((tid >> lh) << (lh + 3)) + j;
        float2 x[8];
#pragma unroll
        for (int k = 0; k < 8; ++k) x[k] = X[XP(i + k * h)];
        const float2 w = TW[j << (9 - lh)], w2 = cmul(w, w), w4 = cmul(w2, w2), w2b = make_float2(w2.y, -w2.x);
        const float2 wa1 = make_float2(RS * (w.x + w.y), RS * (w.y - w.x)), wa2 = make_float2(w.y, -w.x), wa3 = make_float2(RS * (w.y - w.x), -RS * (w.x + w.y));
        const float2 u0 = cadd(x[0], x[4]), u1 = cadd(x[1], x[5]), u2 = cadd(x[2], x[6]), u3 = cadd(x[3], x[7]);
        const float2 v0 = cmul(csub(x[0], x[4]), w), v1 = cmul(csub(x[1], x[5]), wa1), v2 = cmul(csub(x[2], x[6]), wa2), v3 = cmul(csub(x[3], x[7]), wa3);
        const float2 p0 = cadd(u0, u2), q0 = cmul(csub(u0, u2), w2), p1 = cadd(u1, u3), q1 = cmul(csub(u1, u3), w2b);
        const float2 r0 = cadd(v0, v2), s0 = cmul(csub(v0, v2), w2), r1 = cadd(v1, v3), s1 = cmul(csub(v1, v3), w2b);
        float2 o[8] = {cadd(p0, p1), cmul(csub(p0, p1), w4), cadd(q0, q1), cmul(csub(q0, q1), w4), cadd(r0, r1), cmul(csub(r0, r1), w4), cadd(s0, s1), cmul(csub(s0, s1), w4)};
        if (Kmul && lh == 0) {
#pragma unroll
            for (int k = 0; k < 8; ++k) o[k] = cmul(o[k], Kmul[i + k]); }
#pragma unroll
        for (int k = 0; k < 8; ++k) X[XP(i + k * h)] = o[k];
        __syncthreads(); }
}
__device__ __forceinline__ void fft_inv(float2* X, const float2* TW, int tid) {
    const float RS = 0.70710678118654752f;
#pragma unroll 1
    for (int lh = 0; lh <= 9; lh += 3) { const int h = 1 << lh, j = tid & (h - 1), i = ((tid >> lh) << (lh + 3)) + j;
        float2 y[8];
#pragma unroll
        for (int k = 0; k < 8; ++k) y[k] = X[XP(i + k * h)];
        const float2 w = TW[j << (9 - lh)], w2 = cmul(w, w), w4 = cmul(w2, w2), w2b = make_float2(w2.y, -w2.x);
        const float2 wa1 = make_float2(RS * (w.x + w.y), RS * (w.y - w.x)), wa2 = make_float2(w.y, -w.x), wa3 = make_float2(RS * (w.y - w.x), -RS * (w.x + w.y));
        const float2 t1 = cmulc(y[1], w4), t3 = cmulc(y[3], w4), t5 = cmulc(y[5], w4), t7 = cmulc(y[7], w4);
        const float2 p0 = cadd(y[0], t1), p1 = csub(y[0], t1), q0 = cadd(y[2], t3), q1 = csub(y[2], t3), r0 = cadd(y[4], t5), r1 = csub(y[4], t5), s0 = cadd(y[6], t7), s1 = csub(y[6], t7);
        const float2 a0 = cmulc(q0, w2), a1 = cmulc(q1, w2b), b0 = cmulc(s0, w2), b1 = cmulc(s1, w2b);
        const float2 u0 = cadd(p0, a0), u2 = csub(p0, a0), u1 = cadd(p1, a1), u3 = csub(p1, a1), v0 = cadd(r0, b0), v2 = csub(r0, b0), v1 = cadd(r1, b1), v3 = csub(r1, b1);
        const float2 c0 = cmulc(v0, w), c1 = cmulc(v1, wa1), c2 = cmulc(v2, wa2), c3 = cmulc(v3, wa3);
        X[XP(i)] = cadd(u0, c0); X[XP(i + 4 * h)] = csub(u0, c0); X[XP(i + h)] = cadd(u1, c1); X[XP(i + 5 * h)] = csub(u1, c1);
        X[XP(i + 2 * h)] = cadd(u2, c2); X[XP(i + 6 * h)] = csub(u2, c2); X[XP(i + 3 * h)] = cadd(u3, c3); X[XP(i + 7 * h)] = csub(u3, c3);
        __syncthreads(); }
}
struct RowSeg { u32x4 m; unsigned lr; };
__device__ __forceinline__ RowSeg row_fetch(const bf16_t* p, int i0) {
    RowSeg r; r.m = *(const u32x4*)(p + i0);
    const unsigned lft = (i0 > 0) ? (unsigned)p[i0 - 1] : 0u, rgt = (i0 + 8 < L) ? (unsigned)p[i0 + 8] : 0u; r.lr = lft | (rgt << 16); return r; }
__device__ __forceinline__ void conv3_seg(const RowSeg& r, float w0, float w1, float w2, float bias, float* out) {
    float v[10]; unpack8(r.m, v + 1); v[0] = bflo(r.lr); v[9] = bfhi(r.lr);
#pragma unroll
    for (int q = 0; q < 8; ++q) out[q] = w0 * v[q] + w1 * v[q + 1] + w2 * v[q + 2] + bias;
}
__device__ __forceinline__ void fft_item(const Ctx& c, int l, int ch, const float* W3, const float* CW, const float* CB, const float* HB) {
    float2* TW = (float2*)c.lds; float2* X = TW + 2048; float2* KEs = X + 4224; float2* KOs = KEs + 4096;
    const float2* TW8 = (const float2*)(c.ws + WS_TW8);
    const int tid = c.tid;
    { const float dmin = -3.0701134573253944f, dmax = -15.350567286626973f;
      const float delta = fabsf(dmin + (dmax - dmin) * (float)ch / 511.0f);
      const float* tf = (const float*)(c.ws + WS_TAPS) + (size_t)ch * 4096; const float* tb = tf + (size_t)512 * 4096;
#pragma unroll
      for (int q = 0; q < 8; ++q) { const int i = tid + 512 * q;
          const float sf = tf[i] * __expf(-((float)i / 4095.0f) * delta);
          const int tbi = (i >= 1) ? L - i : 1; const float sb = (i >= 1) ? tb[tbi] * __expf(-((float)tbi / 4095.0f) * delta) : 0.f;
          const float2 w = TW8[i]; const float ov = sf - sb;
          X[XP(i)] = make_float2(sf + sb, 0.f); KOs[i] = make_float2(ov * w.x, ov * w.y); }
      __syncthreads(); fft_fwd(X, TW, tid);
#pragma unroll
      for (int q = 0; q < 8; ++q) { const int i = tid + 512 * q; KEs[i] = X[XP(i)]; X[XP(i)] = KOs[i]; }
      __syncthreads(); fft_fwd(X, TW, tid);
#pragma unroll
      for (int q = 0; q < 8; ++q) KOs[tid + 512 * q] = X[XP(tid + 512 * q)];
      __syncthreads(); }
    const float* cw = CW + (size_t)l * 3 * 1536; const float* cb = CB + (size_t)l * 1536;
    const float hb = (HB + (size_t)l * 512)[ch];
    bf16_t* UT = (bf16_t*)(c.ws + WS_UT);
    const int i0 = tid * 8;
    RowSeg rs[2][3];
#pragma unroll
    for (int bb = 0; bb < 2; ++bb)
#pragma unroll
        for (int r = 0; r < 3; ++r) rs[bb][r] = row_fetch(UT + ((size_t)bb * 1536 + r * 512 + ch) * 4096, i0);
#pragma unroll 1
    for (int p = 0; p < 4; ++p) {
        float zv[2][8], x0c[2][8];
#pragma unroll
        for (int bb = 0; bb < 2; ++bb) { float x1c[8], vc[8];
            conv3_seg(rs[bb][0], cw[ch], cw[1536 + ch], cw[3072 + ch], cb[ch], x0c[bb]);
            conv3_seg(rs[bb][1], cw[512 + ch], cw[1536 + 512 + ch], cw[3072 + 512 + ch], cb[512 + ch], x1c);
            conv3_seg(rs[bb][2], cw[1024 + ch], cw[1536 + 1024 + ch], cw[3072 + 1024 + ch], cb[1024 + ch], vc);
#pragma unroll
            for (int q = 0; q < 8; ++q) zv[bb][q] = x1c[q] * vc[q]; }
        float2 A[8];
#pragma unroll
        for (int q = 0; q < 8; ++q) X[XP(i0 + q)] = make_float2(zv[0][q], zv[1][q]);
        __syncthreads(); fft_fwd(X, TW, tid, KEs); fft_inv(X, TW, tid);
#pragma unroll
        for (int q = 0; q < 8; ++q) A[q] = X[XP(i0 + q)];
        __syncthreads();
#pragma unroll
        for (int q = 0; q < 8; ++q) X[XP(i0 + q)] = cmul(make_float2(zv[0][q], zv[1][q]), TW8[i0 + q]);
        __syncthreads(); fft_fwd(X, TW, tid, KOs);
        if (p < 3) {
#pragma unroll
            for (int bb = 0; bb < 2; ++bb)
#pragma unroll
                for (int r = 0; r < 3; ++r) rs[bb][r] = row_fetch(UT + ((size_t)(2 * p + 2 + bb) * 1536 + r * 512 + ch) * 4096, i0); }
        fft_inv(X, TW, tid);
        float o0[8], o1[8];
#pragma unroll
        for (int q = 0; q < 8; ++q) { float2 w = TW8[i0 + q]; w.y = -w.y; const float2 bq = cmul(X[XP(i0 + q)], w);
            const float yr = (A[q].x + bq.x) * (1.0f / 8192.0f), yi = (A[q].y + bq.y) * (1.0f / 8192.0f);
            o0[q] = x0c[0][q] * (yr + zv[0][q] * hb); o1[q] = x0c[1][q] * (yi + zv[1][q] * hb); }
        *(u32x4*)(UT + ((size_t)(2 * p) * 1536 + ch) * 4096 + i0) = pack8(o0);
        *(u32x4*)(UT + ((size_t)(2 * p + 1) * 1536 + ch) * 4096 + i0) = pack8(o1);
        __syncthreads();
    }
}

__device__ __forceinline__ void gla_item(const Ctx& c, int l, int it, const float* GW2, const float* GB) {
    const int tid = c.tid, lane = c.lane, w = c.wave;
    const int slice = it & 1, dir = (it >> 1) & 1, h = (it >> 2) & 3, b = it >> 4;
    constexpr int BS = 129;
    float* Bc = (float*)c.lds;
    bf16_t* QE = (bf16_t*)(c.lds + 33792);
    bf16_t* KE = QE + 64 * 136;
    bf16_t* KDT = KE + 64 * 136;
    bf16_t* VT = KDT + 128 * 72;
    bf16_t* P = VT + 64 * 72;
    bf16_t* ST = P + 64 * 72;
    float* EBL = (float*)(ST + 64 * 136);
    const bf16_t* QKVG = (const bf16_t*)(c.ws + WS_QKVG); const bf16_t* LRB = (const bf16_t*)(c.ws + WS_LR);
    bf16_t* Od = (bf16_t*)(c.ws + (dir ? WS_OB : WS_YGLA));
    const float* gw2 = GW2 + (size_t)l * 2 * 16 * 512; const float* gb = GB + (size_t)l * 2 * 512;
    const int lr_ = lane & 15, lq = lane >> 4;
    bf16x8 w2f = (bf16x8){0, 0, 0, 0, 0, 0, 0, 0};
    if (lq < 2) {
#pragma unroll
        for (int i = 0; i < 8; ++i) w2f[i] = (short)f2bf(gw2[(size_t)(dir * 16 + lq * 8 + i) * 512 + h * 128 + 16 * w + lr_]); }
    const float gbias = gb[dir * 512 + h * 128 + 16 * w + lr_];
    f32x4 S[4]; S[0] = (f32x4){0.f, 0.f, 0.f, 0.f}; S[1] = S[0]; S[2] = S[0]; S[3] = S[0];
    for (int i = tid; i < 64 * 136 / 2; i += 512) ((unsigned*)ST)[i] = 0u;
    const int j8 = tid >> 3, e8 = (tid & 7) * 8, d0 = 16 * w;
    u32x4 lrf[4]; u32x4 vv; u32x4 qv[2], kv[2];
    { const int n = dir ? 63 : 0; const size_t rbase = (size_t)b * L + (size_t)n * 64;
      const size_t row8 = rbase + (dir ? 63 - j8 : j8), rowl = rbase + (dir ? 63 - lane : lane);
#pragma unroll
      for (int jt = 0; jt < 4; ++jt) { const int j = jt * 16 + lr_; lrf[jt] = (lq < 2) ? *(const u32x4*)(LRB + (rbase + (dir ? 63 - j : j)) * 32 + dir * 16 + lq * 8) : (u32x4){0u, 0u, 0u, 0u}; }
      vv = *(const u32x4*)(QKVG + row8 * 2048 + 1024 + h * 128 + slice * 64 + e8);
      const u32x4* qp = (const u32x4*)(QKVG + rowl * 2048 + h * 128 + d0); qv[0] = qp[0]; qv[1] = qp[1];
      const u32x4* kp = (const u32x4*)(QKVG + rowl * 2048 + 512 + h * 128 + d0); kv[0] = kp[0]; kv[1] = kp[1]; }
#pragma unroll 1
    for (int nn = 0; nn < 64; ++nn) {
        const int n = dir ? 63 - nn : nn;
        const size_t rbase = (size_t)b * L + (size_t)n * 64;
        VT[(e8 + 0) * 72 + j8] = (bf16_t)(vv.x & 0xffffu); VT[(e8 + 1) * 72 + j8] = (bf16_t)(vv.x >> 16); VT[(e8 + 2) * 72 + j8] = (bf16_t)(vv.y & 0xffffu); VT[(e8 + 3) * 72 + j8] = (bf16_t)(vv.y >> 16);
        VT[(e8 + 4) * 72 + j8] = (bf16_t)(vv.z & 0xffffu); VT[(e8 + 5) * 72 + j8] = (bf16_t)(vv.z >> 16); VT[(e8 + 6) * 72 + j8] = (bf16_t)(vv.w & 0xffffu); VT[(e8 + 7) * 72 + j8] = (bf16_t)(vv.w >> 16);
        const u32x4 q0 = qv[0], q1 = qv[1], k0 = kv[0], k1 = kv[1], l0 = lrf[0], l1 = lrf[1], l2 = lrf[2], l3 = lrf[3];
        if (nn < 63) { const int n2 = dir ? 62 - nn : nn + 1; const size_t rb2 = (size_t)b * L + (size_t)n2 * 64;
            const size_t row8 = rb2 + (dir ? 63 - j8 : j8), rowl = rb2 + (dir ? 63 - lane : lane);
#pragma unroll
            for (int jt = 0; jt < 4; ++jt) { const int j = jt * 16 + lr_; lrf[jt] = (lq < 2) ? *(const u32x4*)(LRB + (rb2 + (dir ? 63 - j : j)) * 32 + dir * 16 + lq * 8) : (u32x4){0u, 0u, 0u, 0u}; }
            vv = *(const u32x4*)(QKVG + row8 * 2048 + 1024 + h * 128 + slice * 64 + e8);
            const u32x4* qp = (const u32x4*)(QKVG + rowl * 2048 + h * 128 + d0); qv[0] = qp[0]; qv[1] = qp[1];
            const u32x4* kp = (const u32x4*)(QKVG + rowl * 2048 + 512 + h * 128 + d0); kv[0] = kp[0]; kv[1] = kp[1]; }
        { const u32x4 lfr[4] = {l0, l1, l2, l3}; float base = 0.f;
#pragma unroll
          for (int jt = 0; jt < 4; ++jt) { f32x4 g = (f32x4){gbias, gbias, gbias, gbias};
              bf16x8 a; { union { u32x4 u; bf16x8 v; } cv; cv.u = lfr[jt]; a = cv.v; }
              g = __builtin_amdgcn_mfma_f32_16x16x32_bf16(a, w2f, g, 0, 0, 0);
              float cs[4]; float run = 0.f;
#pragma unroll
              for (int r = 0; r < 4; ++r) { const float gk = g[r]; const float ls = fminf(gk, 0.f) - 0.69314718056f * __builtin_amdgcn_logf(1.0f + __builtin_amdgcn_exp2f(-1.44269504089f * fabsf(gk))); run += fmaxf(ls * (1.0f / 16.0f), -1.0f); cs[r] = run; }
              const float x1 = __shfl_up(run, 16), x2 = __shfl_up(run, 32), x3 = __shfl_up(run, 48);
              const float excl = (lq >= 1 ? x1 : 0.f) + (lq >= 2 ? x2 : 0.f) + (lq >= 3 ? x3 : 0.f);
              const float tot = __shfl(excl + run, 48 + lr_);
#pragma unroll
              for (int r = 0; r < 4; ++r) Bc[(jt * 16 + lq * 4 + r) * BS + 16 * w + lr_] = base + excl + cs[r];
              base += tot; }
          if (lq == 0) EBL[16 * w + lr_] = __builtin_amdgcn_exp2f(1.44269504089f * base); }
        __syncthreads();
        { float qe[16], ke[16], q[16], k[16]; unpack8(q0, q); unpack8(q1, q + 8); unpack8(k0, k); unpack8(k1, k + 8);
#pragma unroll
          for (int i = 0; i < 16; ++i) { const int d = d0 + i; const float e1 = __builtin_amdgcn_exp2f(1.44269504089f * Bc[lane * BS + d]), e2 = __builtin_amdgcn_rcpf(e1);
              qe[i] = q[i] * 0.08838834764831845f * e1; ke[i] = k[i] * e2;
              KDT[d * 72 + lane] = f2bf(k[i] * e2 * EBL[d]); }
          *(u32x4*)(QE + lane * 136 + d0) = pack8(qe); *(u32x4*)(QE + lane * 136 + d0 + 8) = pack8(qe + 8);
          *(u32x4*)(KE + lane * 136 + d0) = pack8(ke); *(u32x4*)(KE + lane * 136 + d0 + 8) = pack8(ke + 8); }
        __syncthreads();
#pragma unroll
        for (int i = 0; i < 2; ++i) { const int tile = 2 * w + i, jt = tile >> 2, st = tile & 3;
            f32x4 acc = (f32x4){0.f, 0.f, 0.f, 0.f};
            if (st <= jt) {
#pragma unroll
                for (int kk = 0; kk < 4; ++kk) { const bf16x8 a = *(const bf16x8*)(QE + (jt * 16 + lr_) * 136 + kk * 32 + lq * 8);
                    const bf16x8 bv = *(const bf16x8*)(KE + (st * 16 + lr_) * 136 + kk * 32 + lq * 8);
                    acc = __builtin_amdgcn_mfma_f32_16x16x32_bf16(a, bv, acc, 0, 0, 0); } }
#pragma unroll
            for (int r = 0; r < 4; ++r) { const int j = jt * 16 + lq * 4 + r, s = st * 16 + lr_; const bool keep = dir ? (s < j) : (s <= j);
                P[j * 72 + s] = f2bf(keep ? acc[r] : 0.f); } }
        __syncthreads();
#pragma unroll
        for (int eh = 0; eh < 2; ++eh) { const int jt = w >> 1, et = 2 * (w & 1) + eh; f32x4 acc = (f32x4){0.f, 0.f, 0.f, 0.f};
#pragma unroll
          for (int kk = 0; kk < 2; ++kk) { const bf16x8 a = *(const bf16x8*)(P + (jt * 16 + lr_) * 72 + kk * 32 + lq * 8);
              const bf16x8 bv = *(const bf16x8*)(VT + (et * 16 + lr_) * 72 + kk * 32 + lq * 8);
              acc = __builtin_amdgcn_mfma_f32_16x16x32_bf16(a, bv, acc, 0, 0, 0); }
#pragma unroll
          for (int kk = 0; kk < 4; ++kk) { const bf16x8 a = *(const bf16x8*)(QE + (jt * 16 + lr_) * 136 + kk * 32 + lq * 8);
              const bf16x8 bv = *(const bf16x8*)(ST + (et * 16 + lr_) * 136 + kk * 32 + lq * 8);
              acc = __builtin_amdgcn_mfma_f32_16x16x32_bf16(a, bv, acc, 0, 0, 0); }
#pragma unroll
          for (int r = 0; r < 4; ++r) { const int j = jt * 16 + lq * 4 + r, e = et * 16 + lr_; const size_t row = rbase + (dir ? 63 - j : j);
              Od[row * 512 + h * 128 + slice * 64 + e] = f2bf(acc[r]); } }
#pragma unroll
        for (int et = 0; et < 4; ++et) { f32x4 acc;
#pragma unroll
            for (int r = 0; r < 4; ++r) acc[r] = S[et][r] * EBL[16 * w + lq * 4 + r];
#pragma unroll
            for (int kk = 0; kk < 2; ++kk) { const bf16x8 a = *(const bf16x8*)(KDT + (16 * w + lr_) * 72 + kk * 32 + lq * 8);
                const bf16x8 bv = *(const bf16x8*)(VT + (et * 16 + lr_) * 72 + kk * 32 + lq * 8);
                acc = __builtin_amdgcn_mfma_f32_16x16x32_bf16(a, bv, acc, 0, 0, 0); }
            S[et] = acc; }
        __syncthreads();
#pragma unroll
        for (int et = 0; et < 4; ++et) { u32x2 wv; wv.x = (unsigned)f2bf(S[et][0]) | ((unsigned)f2bf(S[et][1]) << 16); wv.y = (unsigned)f2bf(S[et][2]) | ((unsigned)f2bf(S[et][3]) << 16);
            *(u32x2*)(ST + (et * 16 + lr_) * 136 + 16 * w + lq * 4) = wv; }
    }
    __syncthreads();
}

template <int W>
__device__ __forceinline__ void pool_item(const bf16_t* PB, bf16_t* Y, int row, int c8) {
    const int t = row & 4095, lo = t - W / 2; float s[8], x[8]; u32x4 v[W];
#pragma unroll
    for (int i = 0; i < W; ++i) { const int tt = lo + i; const int tc = min(max(tt, 0), L - 1); v[i] = *(const u32x4*)(PB + (size_t)(row - t + tc) * 512 + c8); }
#pragma unroll
    for (int j = 0; j < 8; ++j) s[j] = 0.f;
#pragma unroll
    for (int i = 0; i < W; ++i) { const int tt = lo + i; const float m = (tt >= 0 && tt < L) ? 1.0f : 0.0f; float f[8]; unpack8(v[i], f);
#pragma unroll
        for (int j = 0; j < 8; ++j) s[j] += m * f[j]; }
    unpack8(v[W / 2], x);
    const float inv = 1.0f / (float)(min(t + W / 2, L) - max(t - W / 2, 0));
#pragma unroll
    for (int j = 0; j < 8; ++j) s[j] = s[j] * inv - x[j];
    *(u32x4*)(Y + (size_t)row * 512 + c8) = pack8(s);
}
__device__ __forceinline__ void pool_stencil(const Ctx& c, int nblk) {
    const bf16_t* PB = (const bf16_t*)(c.ws + WS_POOL); bf16_t* Y = (bf16_t*)(c.ws + WS_YPOOL);
    const int gw = c.bid * 8 + c.wave, NGW = nblk * 8, r4 = c.lane >> 4, ch = (c.lane & 15) * 8;
    if (c.bid >= nblk) return;
    for (int it = gw; it < (M / 4) * 4; it += NGW) { const int g = it & 3, row = (it >> 2) * 4 + r4, c8 = g * 128 + ch;
        if (g == 0) pool_item<2>(PB, Y, row, c8); else if (g == 1) pool_item<4>(PB, Y, row, c8); else if (g == 2) pool_item<8>(PB, Y, row, c8); else pool_item<16>(PB, Y, row, c8); }
}
__device__ __forceinline__ void post_phase(const Ctx& c, int l, const float* GN) {
    const bf16_t* UT = (const bf16_t*)(c.ws + WS_UT); bf16_t* YH = (bf16_t*)(c.ws + WS_YHY);
    { const int qd = c.tid >> 7, tq = c.tid & 127; bf16_t* T = (bf16_t*)c.lds + qd * (64 * 72);
      for (int tile0 = c.bid * 4; tile0 < NB * 8 * 64; tile0 += c.G * 4) { const int tile = tile0 + qd, b = tile >> 9, c0 = ((tile >> 6) & 7) * 64, t0 = (tile & 63) * 64;
#pragma unroll
          for (int hh = 0; hh < 4; ++hh) { const int cc = (tq >> 3) + 16 * hh, t8 = (tq & 7) * 8; *(u32x4*)(T + cc * 72 + t8) = *(const u32x4*)(UT + ((size_t)b * 1536 + c0 + cc) * 4096 + t0 + t8); }
          __syncthreads();
#pragma unroll
          for (int hh = 0; hh < 4; ++hh) { const int tt = (tq >> 3) + 16 * hh, c8 = (tq & 7) * 8; unsigned wv[4];
#pragma unroll
              for (int i = 0; i < 4; ++i) wv[i] = (unsigned)T[(c8 + 2 * i) * 72 + tt] | ((unsigned)T[(c8 + 2 * i + 1) * 72 + tt] << 16);
              u32x4 o; o.x = wv[0]; o.y = wv[1]; o.z = wv[2]; o.w = wv[3];
              *(u32x4*)(YH + ((size_t)b * 4096 + t0 + tt) * 512 + c0 + c8) = o; }
          __syncthreads(); } }
    bf16_t* YG = (bf16_t*)(c.ws + WS_YGLA); const bf16_t* OB = (const bf16_t*)(c.ws + WS_OB); const bf16_t* QKVG = (const bf16_t*)(c.ws + WS_QKVG);
    const float* gn = GN + (size_t)l * 128;
    float gnv[8];
#pragma unroll
    for (int i = 0; i < 8; ++i) gnv[i] = gn[(c.lane & 15) * 8 + i];
    const int NGW = c.G * 8;
    for (int row0 = c.bid * 8 + c.wave; row0 < M; row0 += 2 * NGW) { u32x4 ra[2], rb[2], rg[2];
#pragma unroll
        for (int u = 0; u < 2; ++u) { const int row = (row0 + u * NGW < M) ? row0 + u * NGW : row0;
            ra[u] = *(const u32x4*)(YG + (size_t)row * 512 + c.lane * 8); rb[u] = *(const u32x4*)(OB + (size_t)row * 512 + c.lane * 8); rg[u] = *(const u32x4*)(QKVG + (size_t)row * 2048 + 1536 + c.lane * 8); }
#pragma unroll
        for (int u = 0; u < 2; ++u) { const int row = row0 + u * NGW; if (row >= M) break;
            float a[8], bq[8], g[8]; unpack8(ra[u], a); unpack8(rb[u], bq); unpack8(rg[u], g);
            float ss = 0.f;
#pragma unroll
            for (int i = 0; i < 8; ++i) { a[i] += bq[i]; ss += a[i] * a[i]; }
#pragma unroll
            for (int o = 8; o; o >>= 1) ss += __shfl_xor(ss, o);
            const float r = rsqrtf(ss * (1.0f / 128.0f) + EPS);
#pragma unroll
            for (int i = 0; i < 8; ++i) a[i] = a[i] * r * gnv[i] * g[i] * __builtin_amdgcn_rcpf(1.0f + __expf(-g[i]));
            *(u32x4*)(YG + (size_t)row * 512 + c.lane * 8) = pack8(a); } }
}
__device__ __forceinline__ void act_fixup(const Ctx& c, int l, int pm, const float* CW, const float* CB) {
    bf16_t* ACT = (bf16_t*)(c.ws + WS_ACT); const bf16_t* SIDE = (const bf16_t*)(c.ws + WS_SIDE); const float* cw = CW + (size_t)l * 3 * DFF; const float* cb = CB + (size_t)l * DFF;
    for (int idx = c.tid; idx < 4 * 2 * 352; idx += 512) { const int bl = idx / 704, blk = 4 * pm + bl, rem = idx - bl * 704, e = rem / 352, ch = (rem - e * 352) * 8;
        const int row = blk * 64 + (e ? 63 : 0), t = row & 4095;
        const bf16_t* sb = SIDE + (size_t)blk * 6 * 2816 + ch;
        float am[8], a0[8], ap[8], bv[8], o[8];
        if (e == 0) { unpack8(*(const u32x4*)(sb), a0); unpack8(*(const u32x4*)(sb + 2816), ap); unpack8(*(const u32x4*)(sb + 4 * 2816), bv);
            if (t > 0) unpack8(*(const u32x4*)(sb - 6 * 2816 + 3 * 2816), am); else {
#pragma unroll
                for (int i = 0; i < 8; ++i) am[i] = 0.f; } }
        else { unpack8(*(const u32x4*)(sb + 2 * 2816), am); unpack8(*(const u32x4*)(sb + 3 * 2816), a0); unpack8(*(const u32x4*)(sb + 5 * 2816), bv);
            if (t < L - 1) unpack8(*(const u32x4*)(sb + 6 * 2816), ap); else {
#pragma unroll
                for (int i = 0; i < 8; ++i) ap[i] = 0.f; } }
#pragma unroll
        for (int i = 0; i < 8; i += 2) { f32x2 v; v.x = cw[ch + i] * am[i] + cw[DFF + ch + i] * a0[i] + cw[2 * DFF + ch + i] * ap[i] + cb[ch + i];
            v.y = cw[ch + i + 1] * am[i + 1] + cw[DFF + ch + i + 1] * a0[i + 1] + cw[2 * DFF + ch + i + 1] * ap[i + 1] + cb[ch + i + 1];
            const f32x2 gl = pg8::gelu_pk(v); o[i] = gl.x * bv[i]; o[i + 1] = gl.y * bv[i + 1]; }
        *(u32x4*)(ACT + (size_t)row * 2816 + ch) = pack8(o); }
}

#define LAS __attribute__((address_space(3)))
#define XB_TMO      128
#define XB_XCNT(j)  (256  + 64 * (j))
#define XB_XSUB(j)  (1280 + 64 * (j))
#define XB_XGEN(j)  (2304 + 64 * (j))
#define XB_TOP      3328
#define XB_TOPGEN   3392
#define XCD_BAR_WORDS 3456
#define XB_SPIN_CAP (1u << 18)

__device__ __forceinline__ unsigned xb_ld(unsigned* p)              { return __hip_atomic_load(p, __ATOMIC_RELAXED, __HIP_MEMORY_SCOPE_AGENT); }
__device__ __forceinline__ unsigned xb_add(unsigned* p, unsigned v) { return __hip_atomic_fetch_add(p, v, __ATOMIC_RELAXED, __HIP_MEMORY_SCOPE_AGENT); }
__device__ __forceinline__ unsigned xb_xcc_id() { return (unsigned)__builtin_amdgcn_s_getreg((3 << 11) | 20) & 0xFu; }
#define XB_SPIN(cond, bar) do { unsigned _sp = 0; while (cond) { __builtin_amdgcn_s_sleep(1); \
    if ((++_sp & 255u) == 0u) { if (xb_ld(&(bar)[XB_TMO])) break; if (_sp > XB_SPIN_CAP) { atomicAdd(&(bar)[XB_TMO], 1u); break; } } } } while (0)

struct XcdBarrier {
    unsigned* bar; unsigned x;
    volatile LAS unsigned* st;
};

__device__ __forceinline__ XcdBarrier xcd_barrier_post(unsigned* bar, volatile LAS unsigned* st) {
    XcdBarrier b; b.bar = bar; b.x = xb_xcc_id(); b.st = st;
    if (threadIdx.x == 0) (void)xb_add(&bar[XB_XCNT(b.x)], 1u);
    return b;
}
__device__ __forceinline__ void xcd_barrier_complete(unsigned* bar, unsigned x, unsigned& nloc, unsigned& nx) {
    const unsigned G = gridDim.x * gridDim.y * gridDim.z;
    unsigned sum, cnt, mine, sp = 0u;
    for (;;) {
        sum = 0u; cnt = 0u; mine = 0u;
#pragma unroll
        for (unsigned j = 0; j < 16; ++j) { const unsigned c = xb_ld(&bar[XB_XCNT(j)]); sum += c; cnt += (c > 0u) ? 1u : 0u; mine = (j == x) ? c : mine; }
        if (sum == G) break;
        __builtin_amdgcn_s_sleep(1);
        if ((++sp & 255u) == 0u) { if (xb_ld(&bar[XB_TMO])) break; if (sp > XB_SPIN_CAP) { atomicAdd(&bar[XB_TMO], 1u); break; } }
    }
    nloc = mine > 0u ? mine : 1u; nx = cnt > 0u ? cnt : 1u;
}

__device__ __forceinline__ void xcd_barrier(const XcdBarrier& b) {
    asm volatile("s_waitcnt vmcnt(0)" ::: "memory");
    __syncthreads();
    if (threadIdx.x == 0) {
        unsigned* bar = b.bar;
        __builtin_amdgcn_s_waitcnt(0);
        unsigned nloc = b.st[0], nx = b.st[1];
        if (nloc == 0u) { xcd_barrier_complete(bar, b.x, nloc, nx); b.st[0] = nloc; b.st[1] = nx; }
        const unsigned old = xb_add(&bar[XB_XSUB(b.x)], 1u);
        const unsigned gen = old / nloc;
        if (old + 1u == (gen + 1u) * nloc) {
            __builtin_amdgcn_fence(__ATOMIC_RELEASE, "agent");
            asm volatile("s_waitcnt vmcnt(0)" ::: "memory");
            const unsigned og = xb_add(&bar[XB_TOP], 1u);
            const unsigned tg = og / nx;
            if (og + 1u == (tg + 1u) * nx) xb_add(&bar[XB_TOPGEN], 1u);
            else XB_SPIN(xb_ld(&bar[XB_TOPGEN]) == tg, bar);
            __builtin_amdgcn_fence(__ATOMIC_ACQUIRE, "agent");
            xb_add(&bar[XB_XGEN(b.x)], 1u);
            asm volatile("s_waitcnt vmcnt(0)" ::: "memory");
        } else {
            XB_SPIN(xb_ld(&bar[XB_XGEN(b.x)]) == gen, bar);
            __builtin_amdgcn_fence(__ATOMIC_ACQUIRE, "agent");
            asm volatile("s_waitcnt vmcnt(0)" ::: "memory");
        }
    }
    __syncthreads();
}

__device__ __forceinline__ const void* launder_ptr(const void* p) {
    unsigned long long v = (unsigned long long)p; asm volatile("" : "+s"(v)); return (const void*)v; }
typedef const float* fptr_t;
typedef __attribute__((address_space(4))) const fptr_t* kin_t;
#define IN(i) (kin[i])
__global__ void __launch_bounds__(512, 2) mega_fwd(Args args) {
    extern __shared__ __attribute__((aligned(16))) unsigned char lds[];
    cg::grid_group grid = cg::this_grid();
    Ctx c; c.out = args.out; c.ws = args.ws; c.lds = lds;
    PG8_LAS unsigned char* glds = (PG8_LAS unsigned char*)lds;
    int nbar = 0;
    if (threadIdx.x < 2) ((volatile LAS unsigned*)(glds + 131072))[threadIdx.x] = 0u;
    __syncthreads();
    XcdBarrier xb = xcd_barrier_post((unsigned*)(args.ws + WS_BAR), (volatile LAS unsigned*)(glds + 131072));
#pragma unroll 1
    for (int ph = args.ph_lo; ph < args.ph_hi; ++ph) {
        if (ph > args.ph_lo) { if (args.ph_hi > 1000000) grid.sync(); xcd_barrier(xb); ++nbar; }
        { int t_ = threadIdx.x; asm volatile("" : "+v"(t_)); c.tid = t_; c.lane = t_ & 63; c.wave = __builtin_amdgcn_readfirstlane(t_ >> 6); }
        { int g_ = gridDim.x, b_ = blockIdx.x; asm volatile("" : "+s"(g_), "+s"(b_)); c.G = g_; c.bid = b_; }
        kin_t kin = (kin_t)__builtin_amdgcn_kernarg_segment_ptr(); asm volatile("" : "+s"(kin));
        c.ws = (unsigned char*)launder_ptr(args.ws); c.out = (float*)launder_ptr(args.out);
        bf16_t* const Hb = (bf16_t*)(c.ws + WS_H);
        bf16_t* const XB = (bf16_t*)c.out + (size_t)M * D;
#ifdef DBG_STOP
        if (ph == 100) { const bf16_t* src = (const bf16_t*)(c.ws + DBG_OFF); for (int i = c.bid * 512 + c.tid; i < M * 1024; i += c.G * 512) c.out[i] = bf2f(src[i]); continue; }
#endif
        if (ph == 0) { if (!((PHMASK >> 10) & 1)) continue;
            convert_mix_weights(c, 0, IN(5), IN(19), IN(20), IN(21), IN(22), IN(23), IN(24));
            hyena_hidden(c, IN(8), IN(9), IN(10), IN(11), IN(12), IN(13));
            rowwise(c, IN(0), nullptr, nullptr, nullptr, XB, nullptr, nullptr, IN(1), Hb);
            continue;
        }
        const int l = (ph - 1) / 10, k = (ph - 1) % 10;
        if (!((PHMASK >> k) & 1)) continue;
        if (k == 0) {
            { pg8::Gemm g{(const bf16_t*)(c.ws + WS_WIN), Hb, 1536, M, 1024, 1024, 1024}; pg8::StaticOrder S; S.init(1536, M, c.G, c.bid);
              EpiUT E{(bf16_t*)(c.ws + WS_UT)}; pg8::gemm_phase<EpiUT, pg8::StaticOrder, true, true>(glds, g, S, E); }
            { pg8::Gemm g{Hb, (const bf16_t*)(c.ws + WS_WIN) + (size_t)1536 * 1024, M, 2816, 1024, 1024, 1024}; pg8::StaticOrder S; S.init(M, 2816, c.G, c.bid);
              EpiProj E{(bf16_t*)(c.ws + WS_QKVG), (bf16_t*)(c.ws + WS_POOL), (bf16_t*)(c.ws + WS_LR)}; pg8::gemm_phase<EpiProj, pg8::StaticOrder, true, true>(glds, g, S, E); }
            if (c.G == 256) hyena_taps(c, l, IN(14), 128, 128); else hyena_taps(c, l, IN(14), 0, c.G);
        } else if (k == 1) {
            const bool split = (c.G >= 256);
            if (!split || c.bid < 128) for (int it = c.bid; it < 128; it += (split ? 128 : c.G)) gla_item(c, l, it, IN(16), IN(17));
            {
                { float2* TW = (float2*)c.lds; const float2* TW8 = (const float2*)(c.ws + WS_TW8);
                  __syncthreads();
                  for (int i = c.tid; i < 2048; i += 512) TW[i] = TW8[2 * i];
                  __syncthreads(); }
                const int ch0 = split ? (c.bid < 128 ? 512 : c.bid - 128) : c.bid, ch1 = 512, chs = split ? 128 : c.G;
#pragma unroll 1
                for (int ch = ch0; ch < ch1; ch += chs) fft_item(c, l, ch, IN(14), IN(6), IN(7), IN(15));
            }
            pool_stencil(c, split ? 128 : c.G);
            if (split) convert_wup(c, l, IN(25), 128);
        } else if (k == 2) {
            post_phase(c, l, IN(18));
        } else if (k == 3) {
            { pg8::Gemm g{Hb, (const bf16_t*)(c.ws + WS_WG), M, 3072, 1024, 1024, 1024}; GateOrder S; S.init(M, 1024, c.G, c.bid);
              EpiGate E{(bf16_t*)(c.ws + WS_TMP)}; pg8::gemm_phase<EpiGate, GateOrder, true, true>(glds, g, S, E); }
#pragma unroll 1
            for (int br = 0; br < 3; ++br) {
                const bf16_t* Y = (const bf16_t*)(c.ws + (br == 0 ? WS_YHY : (br == 1 ? WS_YGLA : WS_YPOOL)));
                pg8::Gemm g{Y, (const bf16_t*)(c.ws + WS_WBR) + (size_t)br * 1024 * 512, M, 1024, 512, 512, 512}; pg8::StaticOrder S; S.init(M, 1024, c.G, c.bid);
                EpiBranch E{(const bf16_t*)(c.ws + WS_TMP) + br * 1024, (bf16_t*)(c.ws + WS_MERGED), br == 0}; pg8::gemm_phase<EpiBranch, pg8::StaticOrder, true, true>(glds, g, S, E);
            }
        } else if (k == 4) {
            pg8::Gemm g{(const bf16_t*)(c.ws + WS_MERGED), (const bf16_t*)(c.ws + WS_WOUT), M, 1024, 1024, 1024, 1024}; pg8::StaticOrder S; S.init(M, 1024, c.G, c.bid);
            EpiPlain E{Hb, 1024}; pg8::gemm_phase<EpiPlain, pg8::StaticOrder, true, true>(glds, g, S, E);
        } else if (k == 5) {
            rowwise(c, nullptr, XB, Hb, IN(2) + (size_t)l * D, (l == DEPTH - 1) ? (bf16_t*)(c.ws + WS_XBW) : XB, nullptr, nullptr, IN(3) + (size_t)l * D, Hb);
            if (c.G < 256) convert_wup(c, l, IN(25), 0);
            convert_wdn(c, l, IN(28));
        } else if (k == 6) {
            pg8::Gemm g{Hb, (const bf16_t*)(c.ws + WS_WUP), M, 5632, 1024, 1024, 1024}; pg8::StaticOrder S; S.init(M, 5632, c.G, c.bid);
            EpiAct E{(bf16_t*)(c.ws + WS_ACT), (bf16_t*)(c.ws + WS_SIDE), IN(26) + (size_t)l * 3 * DFF, IN(27) + (size_t)l * DFF}; pg8::gemm_phase<EpiAct, pg8::StaticOrder, true, true>(glds, g, S, E);
        } else if (k == 7) {
            for (int pm = c.bid; pm < M / 256; pm += c.G) act_fixup(c, l, pm, IN(26), IN(27));
        } else if (k == 8) {
            pg8::Gemm g{(const bf16_t*)(c.ws + WS_ACT), (const bf16_t*)(c.ws + WS_WDN), M, 1024, 2816, 2816, 2816}; pg8::StaticOrder S; S.init(M, 1024, c.G, c.bid);
            EpiPlain E{Hb, 1024}; pg8::gemm_phase<EpiPlain, pg8::StaticOrder, true, true>(glds, g, S, E);
        } else {
            const bool lastl = (l == DEPTH - 1);
            if (!lastl) rowwise(c, nullptr, XB, Hb, IN(4) + (size_t)l * D, XB, nullptr, nullptr, IN(1) + (size_t)(l + 1) * D, Hb);
            else rowwise(c, nullptr, (const bf16_t*)(c.ws + WS_XBW), Hb, IN(4) + (size_t)l * D, nullptr, c.out, c.out + (size_t)(M / 2) * D, nullptr, Hb);
            if (!lastl) convert_mix_weights(c, l + 1, IN(5), IN(19), IN(20), IN(21), IN(22), IN(23), IN(24));
        }
    }
}

extern "C" void kernel_launch(void* const* d_in, const int* in_sizes, int n_in, void* d_out, int out_size, void* d_ws, size_t ws_size, hipStream_t stream) {
    static int grid = 0;
    if (grid == 0) {
        if (n_in != 29 || in_sizes[0] != M * D || out_size != M * D || ws_size < WS_END) { fprintf(stderr, "kernel_launch: unexpected shapes / workspace (%d inputs, ws %zu, need %zu)\n", n_in, ws_size, (size_t)WS_END); grid = -1; return; }
        int dev = 0, cus = 0, per_cu = 0;
        if (hipGetDevice(&dev) != hipSuccess || hipDeviceGetAttribute(&cus, hipDeviceAttributeMultiprocessorCount, dev) != hipSuccess) { grid = -1; return; }
        if (hipFuncSetAttribute((const void*)mega_fwd, hipFuncAttributeMaxDynamicSharedMemorySize, LDS_BYTES) != hipSuccess) { fprintf(stderr, "kernel_launch: hipFuncSetAttribute failed\n"); grid = -1; return; }
        if (hipOccupancyMaxActiveBlocksPerMultiprocessor(&per_cu, (const void*)mega_fwd, 512, LDS_BYTES) != hipSuccess || per_cu < 1) { fprintf(stderr, "kernel_launch: occupancy query says %d\n", per_cu); per_cu = 1; }
        (void)hipGetLastError();
        grid = cus;
    }
    if (grid < 0) return;
    Args a{};
    for (int i = 0; i < 29; ++i) a.in[i] = (const float*)d_in[i];
    a.out = (float*)d_out; a.ws = (unsigned char*)d_ws;
#if MK_PER_PHASE_LAUNCH
#ifdef DBG_STOP
    for (int ph = 0; ph < DBG_STOP; ++ph) { a.ph_lo = ph; a.ph_hi = ph + 1; hipLaunchKernelGGL(mega_fwd, dim3(grid), dim3(512), LDS_BYTES, stream, a); }
    a.ph_lo = 100; a.ph_hi = 101; hipLaunchKernelGGL(mega_fwd, dim3(grid), dim3(512), LDS_BYTES, stream, a);
#else
    for (int ph = 0; ph < N_PHASES; ++ph) { a.ph_lo = ph; a.ph_hi = ph + 1; hipLaunchKernelGGL(mega_fwd, dim3(grid), dim3(512), LDS_BYTES, stream, a); }
#endif
#else
    a.ph_lo = 0; a.ph_hi = N_PHASES;
    if (hipMemsetAsync((unsigned char*)d_ws + WS_BAR, 0, 16384, stream) != hipSuccess) { fprintf(stderr, "kernel_launch: hipMemsetAsync of the barrier words failed\n"); return; }
    void* kargs[] = {&a};
    const hipError_t e = hipLaunchCooperativeKernel((const void*)mega_fwd, dim3(grid), dim3(512), kargs, LDS_BYTES, stream);
    if (e != hipSuccess) fprintf(stderr, "kernel_launch: cooperative launch failed: %s (grid %d)\n", hipGetErrorString(e), grid);
#endif
}
```
